# Optimizing an MI355X kernel written in HIP

```python
import jax, jax.numpy as jnp
from jax import lax
import numpy as np

D_MODEL = 2048
BATCH = 4
SEQ = 8192
DEPTH = 4
DEC_BATCH = 16
DEC_SEQ = 32
PAST_LEN = 4096

CHUNK = 64
N_MIXERS = 2
N_A = (DEPTH + 1) // 2
N_B = DEPTH // 2
ROPE_THETA = 500000.0
EPS = 1e-6
NEG = -1e30
A_HEADS = 16
Q_LORA = 512
KV_LORA = 512
A_NOPE = 128
A_ROPE = 64
A_V = 128
A_QBLOCK = 128
A_SCALE = (A_NOPE + A_ROPE) ** -0.5
B_HEADS = 32
B_KV = 8
B_HD = 64
B_ROT = B_HD // 4
WINDOW = 128
WIN_CHUNKS = WINDOW // CHUNK
B_SCALE = B_HD ** -0.5
D_FF = 5632
CONV_W = 3

kernel_name = 'streaming_mla_swa_convffn_step'


def rmsnorm(x, g):
    xf = x.astype(jnp.float32)
    y = xf * lax.rsqrt(jnp.mean(xf * xf, axis=-1, keepdims=True) + EPS)
    return (y * g.astype(jnp.float32)).astype(x.dtype)


def rope(x, pos, rot):
    half = rot // 2
    inv = ROPE_THETA ** (-jnp.arange(half, dtype=jnp.float32) / half)
    ang = pos.astype(jnp.float32)[:, None] * inv[None, :]
    cos = jnp.cos(ang)[:, None, :]
    sin = jnp.sin(ang)[:, None, :]
    xf = x.astype(jnp.float32)
    x1 = xf[..., :half]
    x2 = xf[..., half:rot]
    out = jnp.concatenate([x1 * cos - x2 * sin, x1 * sin + x2 * cos, xf[..., rot:]], axis=-1)
    return out.astype(x.dtype)


def mla_project(h, pos, w_in, g_q, w_qb, g_kv):
    b, s, _ = h.shape
    a = h @ w_in
    cq = rmsnorm(a[..., :Q_LORA], g_q)
    ckv = rmsnorm(a[..., Q_LORA:Q_LORA + KV_LORA], g_kv)
    kpe = rope(a[..., Q_LORA + KV_LORA:][:, :, None, :], pos, A_ROPE)[:, :, 0, :]
    q = (cq @ w_qb).reshape(b, s, A_HEADS, A_NOPE + A_ROPE)
    q_nope = q[..., :A_NOPE]
    q_pe = rope(q[..., A_NOPE:], pos, A_ROPE)
    return q_nope, q_pe, ckv, kpe


def mla_attend(q_nope, q_pe, q_pos, ckv, kpe, k_pos, w_uk, w_uv):
    q_lat = jnp.einsum('bqhn,rhn->bqhr', q_nope, w_uk)
    s = jnp.einsum('bqhr,bkr->bhqk', q_lat, ckv) + jnp.einsum('bqhe,bke->bhqk', q_pe, kpe)
    s = s.astype(jnp.float32) * A_SCALE
    visible = (k_pos // CHUNK)[None, :] <= (q_pos // CHUNK)[:, None]
    s = jnp.where(visible[None, None], s, NEG)
    p = jax.nn.softmax(s, axis=-1).astype(ckv.dtype)
    o_lat = jnp.einsum('bhqk,bkr->bqhr', p, ckv)
    o = jnp.einsum('bqhr,rhv->bqhv', o_lat, w_uv)
    return o.reshape(o.shape[0], o.shape[1], A_HEADS * A_V)


def mla_mixer(h, pos, past_ckv, past_kpe, w_in, g_q, w_qb, g_kv, w_uk, w_uv, w_o):
    b, s, _ = h.shape
    q_nope, q_pe, ckv, kpe = mla_project(h, pos, w_in, g_q, w_qb, g_kv)
    if past_ckv is None:
        nb = s // A_QBLOCK
        qn_b = q_nope.reshape(b, nb, A_QBLOCK, A_HEADS, A_NOPE).transpose(1, 0, 2, 3, 4)
        qp_b = q_pe.reshape(b, nb, A_QBLOCK, A_HEADS, A_ROPE).transpose(1, 0, 2, 3, 4)
        pos_b = pos.reshape(nb, A_QBLOCK)

        def block(args):
            qn, qp, qpos = args
            return mla_attend(qn, qp, qpos, ckv, kpe, pos, w_uk, w_uv)

        o = lax.map(block, (qn_b, qp_b, pos_b))
        o = o.transpose(1, 0, 2, 3).reshape(b, s, A_HEADS * A_V)
    else:
        past = past_ckv.shape[1]
        k_ckv = jnp.concatenate([past_ckv, ckv], axis=1)
        k_kpe = jnp.concatenate([past_kpe, kpe], axis=1)
        k_pos = jnp.arange(past + s, dtype=jnp.int32)
        o = mla_attend(q_nope, q_pe, pos, k_ckv, k_kpe, k_pos, w_uk, w_uv)
    return o @ w_o, ckv, kpe


def sink_softmax(s, sinks):
    sk = sinks[:, :, None, None]
    m = jnp.maximum(jnp.max(s, axis=-1, keepdims=True), sk)
    e = jnp.exp(s - m)
    return e / (jnp.sum(e, axis=-1, keepdims=True) + jnp.exp(sk - m))


def swa_mixer(h, pos, past_k, past_v, w_qkv, sinks, w_o):
    b, s, _ = h.shape
    g = B_HEADS // B_KV
    qkv = h @ w_qkv
    q = qkv[..., :B_HEADS * B_HD].reshape(b, s, B_HEADS, B_HD)
    k = qkv[..., B_HEADS * B_HD:(B_HEADS + B_KV) * B_HD].reshape(b, s, B_KV, B_HD)
    v = qkv[..., (B_HEADS + B_KV) * B_HD:].reshape(b, s, B_KV, B_HD)
    q = rope(q, pos, B_ROT)
    k = rope(k, pos, B_ROT)
    snk = sinks.astype(jnp.float32).reshape(B_KV, g)
    if past_k is None:
        nc = s // CHUNK
        pad = WIN_CHUNKS * CHUNK
        kp = jnp.pad(k, ((0, 0), (pad, 0), (0, 0), (0, 0))).reshape(b, nc + WIN_CHUNKS, CHUNK, B_KV, B_HD)
        vp = jnp.pad(v, ((0, 0), (pad, 0), (0, 0), (0, 0))).reshape(b, nc + WIN_CHUNKS, CHUNK, B_KV, B_HD)
        band_k = jnp.concatenate([kp[:, j:j + nc] for j in range(WIN_CHUNKS + 1)], axis=2)
        band_v = jnp.concatenate([vp[:, j:j + nc] for j in range(WIN_CHUNKS + 1)], axis=2)
        key_chunk = (jnp.arange(nc)[:, None]
                     + (jnp.arange((WIN_CHUNKS + 1) * CHUNK) // CHUNK)[None, :] - WIN_CHUNKS)
        visible = key_chunk >= 0
        qc = q.reshape(b, nc, CHUNK, B_KV, g, B_HD)
        sc = jnp.einsum('bcqkgd,bcskd->bckgqs', qc, band_k).astype(jnp.float32) * B_SCALE
        sc = jnp.where(visible[None, :, None, None, None, :], sc, NEG)
        p = sink_softmax(sc, snk).astype(v.dtype)
        o = jnp.einsum('bckgqs,bcskd->bcqkgd', p, band_v).reshape(b, s, B_HEADS * B_HD)
        kw = min(WINDOW, s)
        new_k = k[:, s - kw:]
        new_v = v[:, s - kw:]
    else:
        w = past_k.shape[1]
        k_all = jnp.concatenate([past_k, k], axis=1)
        v_all = jnp.concatenate([past_v, v], axis=1)
        k_pos = pos[0] - w + jnp.arange(w + s, dtype=jnp.int32)
        qch = pos // CHUNK
        kch = k_pos // CHUNK
        visible = (kch[None, :] <= qch[:, None]) & (kch[None, :] >= qch[:, None] - WIN_CHUNKS)
        qg = q.reshape(b, s, B_KV, g, B_HD)
        sc = jnp.einsum('bqkgd,bskd->bkgqs', qg, k_all).astype(jnp.float32) * B_SCALE
        sc = jnp.where(visible[None, None, None], sc, NEG)
        p = sink_softmax(sc, snk).astype(v.dtype)
        o = jnp.einsum('bkgqs,bskd->bqkgd', p, v_all).reshape(b, s, B_HEADS * B_HD)
        new_k = k_all[:, -w:]
        new_v = v_all[:, -w:]
    return o @ w_o, new_k, new_v


def conv_ffn(h, prev, w_in, conv_w, conv_b, w_down):
    b, s, _ = h.shape
    gu = h @ w_in
    gate = gu[..., :D_FF]
    up = gu[..., D_FF:]
    if prev is None:
        prev = jnp.zeros((b, CONV_W - 1, D_FF), gate.dtype)
    gp = jnp.concatenate([prev, gate], axis=1)
    conv = conv_b + conv_w[0] * gp[:, 0:s]
    for j in range(1, CONV_W):
        conv = conv + conv_w[j] * gp[:, j:j + s]
    y = (jax.nn.silu(conv) * up) @ w_down
    return y, gp[:, -(CONV_W - 1):]


def setup_inputs(seed: int = 0) -> dict:
    key = jax.random.key(seed)
    ks = jax.random.split(key, 24)
    f32 = jnp.float32

    def nrm(k, shape, fan_in):
        return jax.random.normal(k, shape, f32) * fan_in ** -0.5

    w_c = min(WINDOW, PAST_LEN)
    return {
        'x_prompt': jax.random.normal(ks[0], (BATCH, SEQ, D_MODEL), f32),
        'x_sample': jax.random.normal(ks[1], (DEC_BATCH, DEC_SEQ, D_MODEL), f32),
        'cache_ckv': jax.random.normal(ks[2], (N_A, DEC_BATCH, PAST_LEN, KV_LORA), f32),
        'cache_kpe': jax.random.normal(ks[3], (N_A, DEC_BATCH, PAST_LEN, A_ROPE), f32),
        'cache_win_k': jax.random.normal(ks[4], (N_B, DEC_BATCH, w_c, B_KV, B_HD), f32),
        'cache_win_v': jax.random.normal(ks[5], (N_B, DEC_BATCH, w_c, B_KV, B_HD), f32),
        'state_ffn_conv': jax.random.normal(ks[6], (DEPTH, DEC_BATCH, CONV_W - 1, D_FF), f32),
        'norm_g': 1.0 + 0.05 * jax.random.normal(ks[7], (DEPTH, 4, D_MODEL), f32),
        'mla_w_in': nrm(ks[8], (N_A, D_MODEL, Q_LORA + KV_LORA + A_ROPE), D_MODEL),
        'mla_g_q': 1.0 + 0.05 * jax.random.normal(ks[9], (N_A, Q_LORA), f32),
        'mla_w_qb': nrm(ks[10], (N_A, Q_LORA, A_HEADS * (A_NOPE + A_ROPE)), Q_LORA),
        'mla_g_kv': 1.0 + 0.05 * jax.random.normal(ks[11], (N_A, KV_LORA), f32),
        'mla_w_uk': nrm(ks[12], (N_A, KV_LORA, A_HEADS, A_NOPE), KV_LORA),
        'mla_w_uv': nrm(ks[13], (N_A, KV_LORA, A_HEADS, A_V), KV_LORA),
        'mla_w_o': nrm(ks[14], (N_A, A_HEADS * A_V, D_MODEL), A_HEADS * A_V),
        'swa_w_qkv': nrm(ks[15], (N_B, D_MODEL, (B_HEADS + 2 * B_KV) * B_HD), D_MODEL),
        'swa_sinks': 0.5 * jax.random.normal(ks[16], (N_B, B_HEADS), f32),
        'swa_w_o': nrm(ks[17], (N_B, B_HEADS * B_HD, D_MODEL), B_HEADS * B_HD),
        'ffn_w_in': nrm(ks[18], (DEPTH, D_MODEL, 2 * D_FF), D_MODEL),
        'ffn_conv_w': nrm(ks[19], (DEPTH, CONV_W, D_FF), CONV_W),
        'ffn_conv_b': 0.02 * jax.random.normal(ks[20], (DEPTH, D_FF), f32),
        'ffn_w_down': nrm(ks[21], (DEPTH, D_FF, D_MODEL), D_FF),
    }


def reference(x_prompt, x_sample, cache_ckv, cache_kpe, cache_win_k, cache_win_v, state_ffn_conv,
              norm_g, mla_w_in, mla_g_q, mla_w_qb, mla_g_kv, mla_w_uk, mla_w_uv, mla_w_o,
              swa_w_qkv, swa_sinks, swa_w_o, ffn_w_in, ffn_conv_w, ffn_conv_b, ffn_w_down):
    xp = x_prompt
    xs = x_sample
    past_len = cache_ckv.shape[2]
    pos_p = jnp.arange(xp.shape[1], dtype=jnp.int32)
    pos_s = past_len + jnp.arange(xs.shape[1], dtype=jnp.int32)
    ckv_p, kpe_p, wk_p, wv_p, fc_p = [], [], [], [], []
    ckv_s, kpe_s, wk_s, wv_s, fc_s = [], [], [], [], []
    for i in range(DEPTH):
        g = norm_g[i]
        if i % N_MIXERS == 0:
            a = i // N_MIXERS
            wts = (mla_w_in[a], mla_g_q[a], mla_w_qb[a], mla_g_kv[a], mla_w_uk[a], mla_w_uv[a], mla_w_o[a])
            mp, c_p, k_p = mla_mixer(rmsnorm(xp, g[0]), pos_p, None, None, *wts)
            ms, c_s, k_s = mla_mixer(rmsnorm(xs, g[0]), pos_s, cache_ckv[a], cache_kpe[a], *wts)
            ckv_p.append(c_p)
            kpe_p.append(k_p)
            ckv_s.append(c_s)
            kpe_s.append(k_s)
        else:
            j = i // N_MIXERS
            wts = (swa_w_qkv[j], swa_sinks[j], swa_w_o[j])
            mp, nk_p, nv_p = swa_mixer(rmsnorm(xp, g[0]), pos_p, None, None, *wts)
            ms, nk_s, nv_s = swa_mixer(rmsnorm(xs, g[0]), pos_s, cache_win_k[j], cache_win_v[j], *wts)
            wk_p.append(nk_p)
            wv_p.append(nv_p)
            wk_s.append(nk_s)
            wv_s.append(nv_s)
        xp = xp + rmsnorm(mp, g[1])
        xs = xs + rmsnorm(ms, g[1])
        fw = (ffn_w_in[i], ffn_conv_w[i], ffn_conv_b[i], ffn_w_down[i])
        fp, cp = conv_ffn(rmsnorm(xp, g[2]), None, *fw)
        fs, cs = conv_ffn(rmsnorm(xs, g[2]), state_ffn_conv[i], *fw)
        fc_p.append(cp)
        fc_s.append(cs)
        xp = xp + rmsnorm(fp, g[3])
        xs = xs + rmsnorm(fs, g[3])
    return (xp, xs,
            jnp.stack(ckv_p), jnp.stack(kpe_p), jnp.stack(wk_p), jnp.stack(wv_p), jnp.stack(fc_p),
            jnp.stack(ckv_s), jnp.stack(kpe_s), jnp.stack(wk_s), jnp.stack(wv_s), jnp.stack(fc_s))
```

```cpp
#include <hip/hip_runtime.h>
#include <cstdio>
#include <cstdint>

#define LAS __attribute__((address_space(3)))
#define GAS __attribute__((address_space(1)))
typedef unsigned short bf16_t;
typedef short bf16x8 __attribute__((ext_vector_type(8)));
typedef short s16x4 __attribute__((ext_vector_type(4)));
typedef float f32x2 __attribute__((ext_vector_type(2)));
typedef float f32x4 __attribute__((ext_vector_type(4)));
typedef float f32x16 __attribute__((ext_vector_type(16)));
typedef unsigned u32x2 __attribute__((ext_vector_type(2)));
typedef unsigned u32x4 __attribute__((ext_vector_type(4)));

constexpr int DM = 2048, NBP = 4, SEQ = 8192, MP = NBP * SEQ, NBS = 16, SSEQ = 32, MS = NBS * SSEQ, MALL = MP + MS, PAST = 4096, DEPTH = 4;
constexpr int QL = 512, KVL = 512, AROPE = 64, ANOPE = 128, AVD = 128, AH = 16, AQK = 192, AIN = 1088, AINP = 1280, AQB = AH * AQK;
constexpr int BH = 32, BKVH = 8, BHD = 64, BQKV = (BH + 2 * BKVH) * BHD, WIN = 128;
constexpr int DFF = 5632, DFF2 = 2 * DFF;
constexpr int SKEYS = PAST + SSEQ, SKN = 4352, SKK = 4224, QAK = 640, SPITCH = 2 * SKN;
constexpr float EPS = 1e-6f;
constexpr float A_SCALE = 0.07216878364870323f;
constexpr float B_SCALE = 0.125f;
constexpr float LOG2E = 1.4426950408889634f;

constexpr size_t O_YP = 0, O_YS = O_YP + (size_t)MP * DM, O_CKVP = O_YS + (size_t)MS * DM, O_KPEP = O_CKVP + 2ull * MP * KVL, O_WKP = O_KPEP + 2ull * MP * AROPE,
                 O_WVP = O_WKP + 2ull * NBP * WIN * 512, O_FCP = O_WVP + 2ull * NBP * WIN * 512, O_CKVS = O_FCP + 4ull * NBP * 2 * DFF, O_KPES = O_CKVS + 2ull * MS * KVL,
                 O_WKS = O_KPES + 2ull * MS * AROPE, O_WVS = O_WKS + 2ull * NBS * WIN * 512, O_FCS = O_WVS + 2ull * NBS * WIN * 512, O_END = O_FCS + 4ull * NBS * 2 * DFF;

constexpr size_t MiB = 1ull << 20;
constexpr size_t WS_CTL = 0, CTL_ZERO_BYTES = 64 * 1024;
constexpr size_t WS_ROPEA = 1 * MiB, WS_ROPEB = 3 * MiB, WS_RS = 3 * MiB + 512 * 1024;
constexpr size_t WS_W = 4 * MiB;
constexpr size_t W_MLA = WS_W, W_MLA_STRIDE = 22 * MiB;
constexpr size_t W_SWA = WS_W + 44 * MiB, W_SWA_STRIDE = 20 * MiB;
constexpr size_t W_FFN = WS_W + 84 * MiB, W_FFN_STRIDE = 66 * MiB;
constexpr size_t WS_R2 = 352 * MiB;
constexpr size_t WS_R3 = 482 * MiB;
constexpr size_t WS_R4 = 742 * MiB;
constexpr size_t WS_R5 = 1100 * MiB;
constexpr size_t WS_END = 1304 * MiB;
constexpr int CW_BAR = 1024;

__device__ __forceinline__ unsigned f2bf(float f) { unsigned u = __builtin_bit_cast(unsigned, f); return (u + 0x7fffu + ((u >> 16) & 1u)) >> 16; }
__device__ __forceinline__ unsigned cvt_pk_bf16(float lo, float hi) { unsigned r; asm volatile("v_cvt_pk_bf16_f32 %0, %1, %2" : "=v"(r) : "v"(lo), "v"(hi)); return r; }
__device__ __forceinline__ unsigned pk2(float lo, float hi) { return cvt_pk_bf16(lo, hi); }
__device__ __forceinline__ float bf2f(unsigned b) { return __builtin_bit_cast(float, b << 16); }
__device__ __forceinline__ float lane_xor(float v, int lane, int mask) { return __builtin_bit_cast(float, __builtin_amdgcn_ds_bpermute((lane ^ mask) << 2, __builtin_bit_cast(int, v))); }
__device__ __forceinline__ float wave_sum(float v, int lane) {
#pragma unroll
    for (int o = 1; o < 64; o <<= 1) v += lane_xor(v, lane, o);
    return v;
}
__device__ __forceinline__ float wave_max(float v, int lane) {
#pragma unroll
    for (int o = 1; o < 64; o <<= 1) v = fmaxf(v, lane_xor(v, lane, o));
    return v;
}
#define LDS_WAIT() asm volatile("s_waitcnt lgkmcnt(0)" ::: "memory")
#define VM_WAIT() asm volatile("s_waitcnt vmcnt(0)" ::: "memory")
template <int CTRL> __device__ __forceinline__ float dpp_upd(float old, float src) {
    return __builtin_bit_cast(float, __builtin_amdgcn_update_dpp(__builtin_bit_cast(int, old), __builtin_bit_cast(int, src), CTRL, 0xf, 0xf, false));
}
__device__ __forceinline__ int tid_fresh() { int t = threadIdx.x; asm volatile("" : "+v"(t)); return t; }
__device__ __forceinline__ int bx_fresh() { int b = blockIdx.x; asm volatile("" : "+s"(b)); return b; }
__device__ __forceinline__ int row_pos(int R) { return R < MP ? (R & (SEQ - 1)) : PAST + ((R - MP) & (SSEQ - 1)); }

namespace pg8 {
constexpr int BM = 256, BK = 64, HALF = 128, HTB = HALF * BK * 2, STAGE_BYTES = 8 * HTB, NXCD = 8, WGM = 8;
__host__ __device__ __forceinline__ int lds_byte(int r, int c) { const int st = (r >> 4) * 2 + (c >> 5), rr = r & 15, cc = c & 31, ob = rr * 64 + cc * 2; return st * 1024 + (ob ^ (((ob >> 9) & 1) << 5)); }
__host__ __device__ __forceinline__ void stage_rc(int b, int& R, int& C) { const int st = b / 1024, sb = b % 1024, swz = sb ^ (((sb >> 9) & 1) << 5); R = (st >> 1) * 16 + swz / 64; C = (st & 1) * 32 + (swz % 64) / 2; }
__host__ __device__ __forceinline__ int perm32(int rho) { const int n = rho >> 4, i = rho & 15; return 8 * (i >> 2) + 4 * n + (i & 3); }

struct Unit { int pm, pn, pb, pk; };
struct Gemm { const bf16_t* A; const bf16_t* Bt; int K, lda, ldb; size_t sA, sB; size_t sK = 0; };

struct StaticOrder {
    int nM, nN, nwg, G, c;
    __device__ __forceinline__ void init(int M, int N, int G_, int c_) { nM = M / BM; nN = N / BM; nwg = nM * nN; G = G_; c = c_; }
    __device__ __forceinline__ bool next(int i, Unit& u) const {
        const long L = (long)i * G + c; if (L >= nwg) return false;
        int wgid = (int)L; { const int q = nwg / NXCD, r = nwg % NXCD, xcd = wgid % NXCD, off = wgid / NXCD; wgid = (xcd < r ? xcd * (q + 1) : r * (q + 1) + (xcd - r) * q) + off; }
        const int nig = WGM * nN, gid = wgid / nig, fm = gid * WGM, gsz = (nM - fm) < WGM ? (nM - fm) : WGM;
        u.pm = fm + ((wgid % nig) % gsz); u.pn = (wgid % nig) / gsz; u.pb = 0; u.pk = 0; return true;
    }
};
struct BatchSplitOrder {
    int nM, nN, nB, nK, G, c;
    __device__ __forceinline__ bool next(int i, Unit& u) const {
        const int L = i * G + c; if (L >= nB * nK * nM * nN) return false;
        const int t = nM * nN, q = L / t, r = L - q * t; u.pb = q / nK; u.pk = q - u.pb * nK; u.pn = r / nM; u.pm = r - u.pn * nM; return true;
    }
};
struct BatchOrder {
    int nM, nN, nB, G, c;
    __device__ __forceinline__ bool next(int i, Unit& u) const {
        const int L = i * G + c; if (L >= nB * nM * nN) return false;
        u.pb = L / (nM * nN); const int r = L - u.pb * (nM * nN); u.pn = r / nM; u.pm = r - u.pn * nM; u.pk = 0; return true;
    }
};

template <class Epi, class Sched, bool ALIGN_EPI>
__device__ __forceinline__ void gemm_phase(LAS unsigned char* lds, const Gemm g, const Sched& S, const Epi& E) {
    const int tid = tid_fresh(), wid = __builtin_amdgcn_readfirstlane(tid >> 6), lane = tid & 63, wr = wid >> 2, wc = wid & 3, fr = lane & 15, fq = lane >> 4;
    const int K = g.K, nt = K / BK;
    unsigned voffA[2], voffB[2];
#pragma unroll
    for (int i = 0; i < 2; ++i) { int R, C; stage_rc(tid * 16 + i * 8192, R, C); const int Rb = Epi::PERM ? ((R & ~31) + perm32(R & 31)) : R;
        voffA[i] = (unsigned)(R * g.lda + C) * 2u; voffB[i] = (unsigned)(Rb * g.ldb + C) * 2u; }
    const size_t kstep = (size_t)(BK * 2);
    const size_t hstepA = (size_t)HALF * g.lda * 2, hstepB = (size_t)HALF * g.ldb * 2;
    const size_t tstepA = 2 * hstepA, tstepB = 2 * hstepB;
    const unsigned ldsw = (unsigned)wid * 1024u;
    const int aoff = lds_byte(wr * 64 + fr, fq * 8), boff = lds_byte(wc * 32 + fr, fq * 8);
#define PG8_SA(b, h) (((b) * 2 + (h)) * HTB)
#define PG8_SB(b, h) ((4 + (b) * 2 + (h)) * HTB)
#define PG8_STAGE(bufoff, gbase, voff) do { _Pragma("unroll") for (int _i = 0; _i < 2; ++_i) \
        __builtin_amdgcn_global_load_lds((const unsigned*)((const char*)(gbase) + (voff)[_i]), (LAS unsigned*)(lds + (bufoff) + ldsw + _i * 8192), 16, 0, 0); } while (0)
#define PG8_LDA(dst, b, h) do { _Pragma("unroll") for (int m = 0; m < 4; ++m) _Pragma("unroll") for (int k = 0; k < 2; ++k) dst[m][k] = *(const LAS bf16x8*)(lds + PG8_SA(b, h) + aoff + m * 2048 + k * 1024); } while (0)
#define PG8_LDB(dst, b, h) do { _Pragma("unroll") for (int n = 0; n < 2; ++n) _Pragma("unroll") for (int k = 0; k < 2; ++k) dst[n][k] = *(const LAS bf16x8*)(lds + PG8_SB(b, h) + boff + n * 2048 + k * 1024); } while (0)
#define PG8_MMA(ai, bj, At, Bt) do { __builtin_amdgcn_s_setprio(1); _Pragma("unroll") for (int m = 0; m < 4; ++m) _Pragma("unroll") for (int n = 0; n < 2; ++n) _Pragma("unroll") for (int k = 0; k < 2; ++k) \
        acc[ai][bj][m][n] = __builtin_amdgcn_mfma_f32_16x16x32_bf16(Bt[n][k], At[m][k], acc[ai][bj][m][n], 0, 0, 0); __builtin_amdgcn_s_setprio(0); } while (0)
#define PG8_WAIT_V(n) asm volatile("s_waitcnt vmcnt(" #n ")" ::: "memory")
#define PG8_WAIT_L(n) asm volatile("s_waitcnt lgkmcnt(" #n ")" ::: "memory")
#define PG8_BAR __builtin_amdgcn_s_barrier()
#define PG8_SCHED __builtin_amdgcn_sched_barrier(0)
    Unit cur, nxt; int ui = 0;
    if (!S.next(0, cur)) return;
    f32x4 acc[2][2][4][2];
#pragma unroll
    for (int a = 0; a < 2; ++a)
#pragma unroll
        for (int b = 0; b < 2; ++b)
#pragma unroll
            for (int m = 0; m < 4; ++m)
#pragma unroll
                for (int n = 0; n < 2; ++n) acc[a][b][m][n] = (f32x4){0.f, 0.f, 0.f, 0.f};
    bf16x8 At[4][2], B0[2][2], B1[2][2];
    const char* cA = (const char*)g.A + ((size_t)cur.pb * g.sA + (size_t)cur.pk * g.sK) * 2 + (size_t)cur.pm * tstepA;
    const char* cB = (const char*)g.Bt + ((size_t)cur.pb * g.sB + (size_t)cur.pk * g.sK) * 2 + (size_t)cur.pn * tstepB;
    PG8_STAGE(PG8_SB(0, 0), cB, voffB); PG8_STAGE(PG8_SB(0, 1), cB + hstepB, voffB); PG8_STAGE(PG8_SA(0, 0), cA, voffA); PG8_STAGE(PG8_SA(0, 1), cA + hstepA, voffA);
    if (wr == 1) PG8_BAR;
    PG8_WAIT_V(2); PG8_BAR;
    PG8_STAGE(PG8_SB(1, 0), cB + kstep, voffB); PG8_STAGE(PG8_SA(1, 0), cA + kstep, voffA); PG8_STAGE(PG8_SB(1, 1), cB + hstepB + kstep, voffB);
    PG8_WAIT_V(6); PG8_BAR;
    for (;;) {
        const bool has_next = S.next(ui + 1, nxt);
        const char* nA = has_next ? (const char*)g.A + ((size_t)nxt.pb * g.sA + (size_t)nxt.pk * g.sK) * 2 + (size_t)nxt.pm * tstepA : cA;
        const char* nB = has_next ? (const char*)g.Bt + ((size_t)nxt.pb * g.sB + (size_t)nxt.pk * g.sK) * 2 + (size_t)nxt.pn * tstepB : cB;
        for (int t = 0; t < nt; t += 2) {
            const bool last = (t == nt - 2);
            const char* a1 = cA + (size_t)(t + 1) * kstep;
            const char* a2 = last ? nA : cA + (size_t)(t + 2) * kstep; const char* b2 = last ? nB : cB + (size_t)(t + 2) * kstep;
            const char* a3 = a2 + kstep; const char* b3 = b2 + kstep;
            PG8_LDB(B0, 0, 0); PG8_LDB(B1, 0, 1); PG8_SCHED; PG8_LDA(At, 0, 0); PG8_STAGE(PG8_SA(1, 1), a1 + hstepA, voffA);
            PG8_WAIT_V(8); PG8_WAIT_L(0); PG8_BAR; PG8_MMA(0, 0, At, B0); PG8_MMA(0, 1, At, B1); PG8_BAR; PG8_SCHED;
            PG8_LDA(At, 0, 1); PG8_STAGE(PG8_SB(0, 0), b2, voffB); PG8_STAGE(PG8_SB(0, 1), b2 + hstepB, voffB); PG8_STAGE(PG8_SA(0, 0), a2, voffA);
            PG8_WAIT_V(8); PG8_WAIT_L(0); PG8_BAR; PG8_MMA(1, 0, At, B0); PG8_MMA(1, 1, At, B1); PG8_BAR; PG8_SCHED;
            PG8_LDB(B0, 1, 0); PG8_LDB(B1, 1, 1); PG8_SCHED; PG8_LDA(At, 1, 0); PG8_STAGE(PG8_SA(0, 1), a2 + hstepA, voffA);
            PG8_WAIT_V(8); PG8_WAIT_L(0); PG8_BAR; PG8_MMA(0, 0, At, B0); PG8_MMA(0, 1, At, B1); PG8_BAR; PG8_SCHED;
            PG8_LDA(At, 1, 1); PG8_STAGE(PG8_SB(1, 0), b3, voffB); PG8_STAGE(PG8_SB(1, 1), b3 + hstepB, voffB); PG8_STAGE(PG8_SA(1, 0), a3, voffA);
            PG8_WAIT_V(8); PG8_WAIT_L(0); PG8_BAR; PG8_MMA(1, 0, At, B0); PG8_MMA(1, 1, At, B1); PG8_BAR; PG8_SCHED;
        }
        if constexpr (ALIGN_EPI) { if (wr == 0) PG8_BAR; }
        E(acc, cur, wr, wc, fr, fq);
        if (!has_next) break;
#pragma unroll
        for (int a = 0; a < 2; ++a)
#pragma unroll
            for (int b = 0; b < 2; ++b)
#pragma unroll
                for (int m = 0; m < 4; ++m)
#pragma unroll
                    for (int n = 0; n < 2; ++n) acc[a][b][m][n] = (f32x4){0.f, 0.f, 0.f, 0.f};
        cur = nxt; cA = nA; cB = nB; ++ui;
        if constexpr (ALIGN_EPI) { if (wr == 1) PG8_BAR; }
    }
    PG8_WAIT_V(0);
    if constexpr (!ALIGN_EPI) { if (wr == 0) PG8_BAR; }
    PG8_BAR;
#undef PG8_SA
#undef PG8_SB
#undef PG8_STAGE
#undef PG8_LDA
#undef PG8_LDB
#undef PG8_MMA
#undef PG8_WAIT_V
#undef PG8_WAIT_L
#undef PG8_BAR
#undef PG8_SCHED
}

template <bool SCALE> struct EpiF32 {
    static constexpr bool PERM = false;
    float* C; int ldc; size_t sC; const float* rs; size_t sCk = 0;
    __device__ __forceinline__ void operator()(const f32x4 (&acc)[2][2][4][2], const Unit& u, int wr, int wc, int fr, int fq) const {
        const int row0 = u.pm * BM + wr * 64 + fr, col0 = u.pn * BM + wc * 32 + 4 * fq;
        float* base = C + (size_t)u.pb * sC + (size_t)u.pk * sCk;
#pragma unroll
        for (int ai = 0; ai < 2; ++ai)
#pragma unroll
            for (int m = 0; m < 4; ++m) { float* rowp = base + (size_t)(row0 + ai * HALF + m * 16) * ldc + col0; const float sc = SCALE ? rs[row0 + ai * HALF + m * 16] : 1.f;
#pragma unroll
                for (int bj = 0; bj < 2; ++bj)
#pragma unroll
                    for (int n = 0; n < 2; ++n) *(f32x4*)(rowp + bj * HALF + n * 16) = acc[ai][bj][m][n] * sc; }
    }
};
struct EpiBf16 {
    static constexpr bool PERM = true;
    bf16_t* O; int ldc; int split_cols; ptrdiff_t split_stride; size_t sC;
    __device__ __forceinline__ void operator()(const f32x4 (&acc)[2][2][4][2], const Unit& u, int wr, int wc, int fr, int fq) const {
        const int row0 = u.pm * BM + wr * 64 + fr; int colt = u.pn * BM; bf16_t* base = O + (size_t)u.pb * sC;
        if (split_cols) { const int t = colt / split_cols; base += (ptrdiff_t)t * split_stride; colt -= t * split_cols; }
        const int col0 = colt + wc * 32 + 8 * fq;
#pragma unroll
        for (int ai = 0; ai < 2; ++ai)
#pragma unroll
            for (int m = 0; m < 4; ++m) { bf16_t* rowp = base + (size_t)(row0 + ai * HALF + m * 16) * ldc + col0;
#pragma unroll
                for (int bj = 0; bj < 2; ++bj) { const f32x4 v0 = acc[ai][bj][m][0], v1 = acc[ai][bj][m][1];
                    u32x4 w; w.x = cvt_pk_bf16(v0[0], v0[1]); w.y = cvt_pk_bf16(v0[2], v0[3]); w.z = cvt_pk_bf16(v1[0], v1[1]); w.w = cvt_pk_bf16(v1[2], v1[3]);
                    *(u32x4*)(rowp + bj * HALF) = w; } }
    }
};
__device__ __forceinline__ void rope8(f32x4& v0, f32x4& v1, const f32x4 c01, const f32x4 c23) {
    f32x4 a = v0, b = v1;
    v0[0] = a[0] * c01[0] - a[1] * c01[1]; v0[1] = a[0] * c01[1] + a[1] * c01[0];
    v0[2] = a[2] * c01[2] - a[3] * c01[3]; v0[3] = a[2] * c01[3] + a[3] * c01[2];
    v1[0] = b[0] * c23[0] - b[1] * c23[1]; v1[1] = b[0] * c23[1] + b[1] * c23[0];
    v1[2] = b[2] * c23[2] - b[3] * c23[3]; v1[3] = b[2] * c23[3] + b[3] * c23[2];
}
struct EpiQMla {
    static constexpr bool PERM = true;
    bf16_t* Q; const float* ropeA;
    __device__ __forceinline__ void operator()(const f32x4 (&acc)[2][2][4][2], const Unit& u, int wr, int wc, int fr, int fq) const {
        const int row0 = u.pm * BM + wr * 64 + fr, col0 = u.pn * BM + wc * 32 + 8 * fq;
#pragma unroll
        for (int ai = 0; ai < 2; ++ai)
#pragma unroll
            for (int m = 0; m < 4; ++m) { const int R = row0 + ai * HALF + m * 16; const int pos = row_pos(R); bf16_t* rowp = Q + (size_t)R * AQB + col0;
#pragma unroll
                for (int bj = 0; bj < 2; ++bj) { f32x4 v0 = acc[ai][bj][m][0], v1 = acc[ai][bj][m][1];
                    const int col = col0 + bj * HALF, w = col % AQK;
                    if (w >= ANOPE) { const float* cs = ropeA + ((size_t)pos * 32 + ((w - ANOPE) >> 1)) * 2; rope8(v0, v1, *(const f32x4*)cs, *(const f32x4*)(cs + 4)); }
                    u32x4 o; o.x = cvt_pk_bf16(v0[0], v0[1]); o.y = cvt_pk_bf16(v0[2], v0[3]); o.z = cvt_pk_bf16(v1[0], v1[1]); o.w = cvt_pk_bf16(v1[2], v1[3]);
                    *(u32x4*)(rowp + bj * HALF) = o; } }
    }
};
struct EpiQkvSwa {
    static constexpr bool PERM = true;
    bf16_t *Q, *Kb, *Vb, *ksamp, *vsamp; const float* ropeB; float *wkp, *wvp, *wks, *wvs; const float* rs;
    __device__ __forceinline__ void operator()(const f32x4 (&acc)[2][2][4][2], const Unit& u, int wr, int wc, int fr, int fq) const {
        const int row0 = u.pm * BM + wr * 64 + fr, colt = u.pn * BM, col0 = colt + wc * 32 + 8 * fq;
        const int kind = colt < 2048 ? 0 : (colt < 2560 ? 1 : 2);
#pragma unroll
        for (int ai = 0; ai < 2; ++ai)
#pragma unroll
            for (int m = 0; m < 4; ++m) { const int R = row0 + ai * HALF + m * 16; const int pos = row_pos(R); const float sc = rs[R];
#pragma unroll
                for (int bj = 0; bj < 2; ++bj) { f32x4 v0 = acc[ai][bj][m][0] * sc, v1 = acc[ai][bj][m][1] * sc;
                    const int col = col0 + bj * HALF, w = col & 63;
                    const bool rot = (kind != 2) && (w < 16);
                    if (rot) { const float* cs = ropeB + ((size_t)pos * 8 + (w >> 1)) * 2; rope8(v0, v1, *(const f32x4*)cs, *(const f32x4*)(cs + 4)); }
                    u32x4 o; o.x = cvt_pk_bf16(v0[0], v0[1]); o.y = cvt_pk_bf16(v0[2], v0[3]); o.z = cvt_pk_bf16(v1[0], v1[1]); o.w = cvt_pk_bf16(v1[2], v1[3]);
                    if (kind == 0) { *(u32x4*)(Q + (size_t)R * 2048 + col) = o; }
                    else {
                        const int c = col - (kind == 1 ? 2048 : 2560);
                        bf16_t* dst = (kind == 1 ? Kb : Vb) + (size_t)R * 512 + c; *(u32x4*)dst = o;
                        float* outp = nullptr;
                        if (R < MP) { const int t = R & (SEQ - 1); if (t >= SEQ - WIN) outp = (kind == 1 ? wkp : wvp) + ((size_t)(R >> 13) * WIN + (t - (SEQ - WIN))) * 512 + (c - w); }
                        else { const int rs = R - MP, b = rs >> 5, t = rs & 31; outp = (kind == 1 ? wks : wvs) + ((size_t)b * WIN + 96 + t) * 512 + (c - w);
                               bf16_t* sd = (kind == 1 ? ksamp : vsamp) + ((size_t)b * 192 + 128 + t) * 512 + c; *(u32x4*)sd = o; }
                        if (outp) {
                            if (rot) {
#pragma unroll
                                for (int e = 0; e < 8; ++e) { const int vv = w + e; outp[(vv & 1) * 8 + (vv >> 1)] = e < 4 ? v0[e & 3] : v1[e & 3]; }
                            } else { *(f32x4*)(outp + w) = v0; *(f32x4*)(outp + w + 4) = v1; }
                        }
                    } } }
    }
};
struct EpiFfnS {
    static constexpr bool PERM = true;
    float *Gs, *Us; const float* rs;
    __device__ __forceinline__ void operator()(const f32x4 (&acc)[2][2][4][2], const Unit& u, int wr, int wc, int fr, int fq) const {
        const int ch0 = u.pn * HALF + wc * 32 + 8 * fq, r0 = u.pm * BM + wr * 64 + fr;
        float* gs = Gs + (size_t)u.pb * MS * DFF; float* us = Us + (size_t)u.pb * MS * DFF;
#pragma unroll
        for (int ai = 0; ai < 2; ++ai)
#pragma unroll
            for (int m = 0; m < 4; ++m) { const size_t off = (size_t)(r0 + ai * HALF + m * 16) * DFF + ch0; const float sc = rs[MP + r0 + ai * HALF + m * 16];
                *(f32x4*)(gs + off) = acc[ai][0][m][0] * sc; *(f32x4*)(gs + off + 4) = acc[ai][0][m][1] * sc; *(f32x4*)(us + off) = acc[ai][1][m][0] * sc; *(f32x4*)(us + off + 4) = acc[ai][1][m][1] * sc; }
    }
};
struct EpiFfn {
    static constexpr bool PERM = true;
    bf16_t* act; const float* cw; const float* cb; float *Gh, *Uh; const float* rs;
    __device__ __forceinline__ void operator()(const f32x4 (&acc)[2][2][4][2], const Unit& u, int wr, int wc, int fr, int fq) const {
        const int ch0 = u.pn * HALF + wc * 32 + 8 * fq;
        float w0[8], w1[8], w2[8], bb[8];
#pragma unroll
        for (int e = 0; e < 8; ++e) { w0[e] = cw[ch0 + e]; w1[e] = cw[DFF + ch0 + e]; w2[e] = cw[2 * DFF + ch0 + e]; bb[e] = cb[ch0 + e]; }
#pragma unroll
        for (int ai = 0; ai < 2; ++ai) {
            const int blk = u.pm * 4 + ai * 2 + wr;
            float prev[8];
#pragma unroll
            for (int e = 0; e < 8; ++e) prev[e] = 0.f;
#pragma unroll
            for (int m = 0; m < 4; ++m) {
                const int R = u.pm * BM + ai * HALF + wr * 64 + m * 16 + fr;
                float g[8], up[8], a[8]; const float sc = rs[R];
#pragma unroll
                for (int e = 0; e < 4; ++e) { g[e] = acc[ai][0][m][0][e] * sc; g[4 + e] = acc[ai][0][m][1][e] * sc; up[e] = acc[ai][1][m][0][e] * sc; up[4 + e] = acc[ai][1][m][1][e] * sc; }
#pragma unroll
                for (int e = 0; e < 8; ++e) {
                    const float p1 = dpp_upd<0x121>(0.f, prev[e]), s1 = dpp_upd<0x111>(p1, g[e]);
                    const float p2 = dpp_upd<0x122>(0.f, prev[e]), s2 = dpp_upd<0x112>(p2, g[e]);
                    const float cv = bb[e] + w0[e] * s2 + w1[e] * s1 + w2[e] * g[e];
                    a[e] = cv * up[e] * __builtin_amdgcn_rcpf(1.f + __builtin_amdgcn_exp2f(-LOG2E * cv));
                    prev[e] = g[e];
                }
                if (!(m == 0 && fr < 2)) {
                    u32x4 o; o.x = cvt_pk_bf16(a[0], a[1]); o.y = cvt_pk_bf16(a[2], a[3]); o.z = cvt_pk_bf16(a[4], a[5]); o.w = cvt_pk_bf16(a[6], a[7]);
                    *(u32x4*)(act + (size_t)R * DFF + ch0) = o;
                }
                if (m == 0 && fr < 2) {
                    float* gp = Gh + ((size_t)blk * 4 + 2 + fr) * DFF + ch0; float* upp = Uh + ((size_t)blk * 2 + fr) * DFF + ch0;
                    *(f32x4*)gp = (f32x4){g[0], g[1], g[2], g[3]}; *(f32x4*)(gp + 4) = (f32x4){g[4], g[5], g[6], g[7]};
                    *(f32x4*)upp = (f32x4){up[0], up[1], up[2], up[3]}; *(f32x4*)(upp + 4) = (f32x4){up[4], up[5], up[6], up[7]};
                }
                if (m == 3 && fr >= 14) {
                    float* gp = Gh + ((size_t)blk * 4 + (fr - 14)) * DFF + ch0;
                    *(f32x4*)gp = (f32x4){g[0], g[1], g[2], g[3]}; *(f32x4*)(gp + 4) = (f32x4){g[4], g[5], g[6], g[7]};
                }
            }
        }
    }
};
}

namespace att {
#define SBAR() __builtin_amdgcn_sched_barrier(0)
__device__ __forceinline__ int crow(int r, int hi) { return (r & 3) + 8 * (r >> 2) + 4 * hi; }
template <int ROWB> __device__ __forceinline__ int kswz(int row, int colB) { return row * ROWB + (colB ^ (((row >> 1) & 7) << 4)); }
template <int NCB> __device__ __forceinline__ int v_st(int k, int c) { const int kk = (k & ~0xC) | ((k & 4) << 1) | ((k & 8) >> 1); return ((kk >> 3) * NCB + (c >> 5)) * 512 + ((kk & 7) * 32 + (c & 31)) * 2; }
__device__ __forceinline__ int v_rd_base(int lane) { return ((lane & 3) << 3) | (((lane >> 2) & 3) << 6) | (((lane >> 4) & 1) << 5) | (((lane >> 5) & 1) << 8); }
template <int OFF> __device__ __forceinline__ s16x4 tr_read(int vb) { s16x4 r; asm volatile("ds_read_b64_tr_b16 %0, %1 offset:%2" : "=&v"(r) : "v"(vb), "i"(OFF) : "memory"); return r; }

__device__ __forceinline__ void partialSM(f32x16& p0, f32x16& p1, float& m_reg, float& alpha, const float C, const float thr_raw) {
    float pmax = p0[0];
#pragma unroll
    for (int r = 1; r < 16; ++r) pmax = fmaxf(pmax, p0[r]);
#pragma unroll
    for (int r = 0; r < 16; ++r) pmax = fmaxf(pmax, p1[r]);
    { auto rr = __builtin_amdgcn_permlane32_swap(__float_as_uint(pmax), __float_as_uint(pmax), false, false); pmax = fmaxf(__uint_as_float(rr[0]), __uint_as_float(rr[1])); }
    float mn;
    if (__all(pmax - m_reg <= thr_raw)) { mn = m_reg; alpha = 1.f; }
    else { mn = fmaxf(m_reg, pmax); alpha = __builtin_amdgcn_exp2f((m_reg - mn) * C); m_reg = mn; }
    const float mnC = -mn * C;
#pragma unroll
    for (int r = 0; r < 16; ++r) p0[r] = __builtin_amdgcn_exp2f(fmaf(p0[r], C, mnC));
#pragma unroll
    for (int r = 0; r < 16; ++r) p1[r] = __builtin_amdgcn_exp2f(fmaf(p1[r], C, mnC));
}
__device__ __forceinline__ void finishSM(const f32x16& p0, const f32x16& p1, float alpha, float& l_reg, bf16x8& pa0, bf16x8& pa1, bf16x8& pa2, bf16x8& pa3) {
    float ps = 0.f;
#pragma unroll
    for (int r = 0; r < 16; ++r) ps += p0[r];
#pragma unroll
    for (int r = 0; r < 16; ++r) ps += p1[r];
    { auto rr = __builtin_amdgcn_permlane32_swap(__float_as_uint(ps), __float_as_uint(ps), false, false); ps = __uint_as_float(rr[0]) + __uint_as_float(rr[1]); }
    l_reg = l_reg * alpha + ps;
#define PK4(P, BASE, OUT) do { unsigned a0 = cvt_pk_bf16(P[BASE + 0], P[BASE + 1]), a1 = cvt_pk_bf16(P[BASE + 2], P[BASE + 3]);   \
    unsigned b0 = cvt_pk_bf16(P[BASE + 4], P[BASE + 5]), b1 = cvt_pk_bf16(P[BASE + 6], P[BASE + 7]);                              \
    auto r0 = __builtin_amdgcn_permlane32_swap(a0, b0, false, false); auto r1 = __builtin_amdgcn_permlane32_swap(a1, b1, false, false); \
    u32x4 w = {r0[0], r1[0], r0[1], r1[1]}; OUT = __builtin_bit_cast(bf16x8, w); } while (0)
    PK4(p0, 0, pa0); PK4(p0, 8, pa1); PK4(p1, 0, pa2); PK4(p1, 8, pa3);
#undef PK4
}
template <int DQK> __device__ __forceinline__ void qkt(f32x16& p0, f32x16& p1, const LAS unsigned char* Ks, const bf16x8* qr, int r32, int hi) {
    p0 = f32x16{}; p1 = f32x16{};
#pragma unroll
    for (int d0 = 0; d0 < DQK / 16; ++d0) { const int cb = (d0 * 16 + hi * 8) * 2;
        const bf16x8 b0 = *(const LAS bf16x8*)(Ks + kswz<DQK * 2>(r32, cb));
        const bf16x8 b1 = *(const LAS bf16x8*)(Ks + kswz<DQK * 2>(32 + r32, cb));
        p0 = __builtin_amdgcn_mfma_f32_32x32x16_bf16(b0, qr[d0], p0, 0, 0, 0);
        p1 = __builtin_amdgcn_mfma_f32_32x32x16_bf16(b1, qr[d0], p1, 0, 0, 0); }
}
template <int NCB, int D0> __device__ __forceinline__ void pv_one(f32x16& od, int vb, bf16x8 pa0, bf16x8 pa1, bf16x8 pa2, bf16x8 pa3) {
    constexpr int KS = 2 * NCB * 512, HF = NCB * 512;
    const s16x4 l0 = tr_read<D0 * 512 + 0 * KS>(vb), h0 = tr_read<D0 * 512 + 0 * KS + HF>(vb), l1 = tr_read<D0 * 512 + 1 * KS>(vb), h1 = tr_read<D0 * 512 + 1 * KS + HF>(vb);
    const s16x4 l2 = tr_read<D0 * 512 + 2 * KS>(vb), h2 = tr_read<D0 * 512 + 2 * KS + HF>(vb), l3 = tr_read<D0 * 512 + 3 * KS>(vb), h3 = tr_read<D0 * 512 + 3 * KS + HF>(vb);
    asm volatile("s_waitcnt lgkmcnt(0)" ::: "memory"); SBAR();
#define PK(L, H) (bf16x8){L[0], L[1], L[2], L[3], H[0], H[1], H[2], H[3]}
    od = __builtin_amdgcn_mfma_f32_32x32x16_bf16(pa0, PK(l0, h0), od, 0, 0, 0);
    od = __builtin_amdgcn_mfma_f32_32x32x16_bf16(pa1, PK(l1, h1), od, 0, 0, 0);
    od = __builtin_amdgcn_mfma_f32_32x32x16_bf16(pa2, PK(l2, h2), od, 0, 0, 0);
    od = __builtin_amdgcn_mfma_f32_32x32x16_bf16(pa3, PK(l3, h3), od, 0, 0, 0);
#undef PK
}
#define ATT_RESC(NO, a) do { if (__any((a) < 1.f)) { if (hi == 0) al_l[r32] = (a); asm volatile("s_waitcnt lgkmcnt(0)" ::: "memory"); \
    _Pragma("unroll") for (int d = 0; d < NO; ++d) _Pragma("unroll") for (int r = 0; r < 16; ++r) o[d][r] *= al_l[crow(r, hi)]; } } while (0)

constexpr int MLA_KB = 64 * 192 * 2, MLA_VB = 64 * 128 * 2;
constexpr int MLA_LDS = 2 * MLA_KB + 2 * MLA_VB + 8 * 256;
__device__ __forceinline__ void mla_unit(LAS unsigned char* lds, int b, int h, int qb, const bf16_t* __restrict__ Q, const bf16_t* __restrict__ KN, const bf16_t* __restrict__ KPE,
                                         const bf16_t* __restrict__ V, bf16_t* __restrict__ O) {
    const int tid = tid_fresh(), lane = tid & 63, r32 = lane & 31, hi = lane >> 5; const int wid = __builtin_amdgcn_readfirstlane(tid >> 6);
    LAS unsigned char* Kl = lds; LAS unsigned char* Vl = lds + 2 * MLA_KB; LAS float* al_l = (LAS float*)(lds + 2 * MLA_KB + 2 * MLA_VB) + wid * 64;
    const size_t rowbase = (size_t)b * SEQ; const int q0 = qb * 256;
    const bf16_t* Qw = Q + (rowbase + q0 + wid * 32 + r32) * AQB + h * AQK + hi * 8;
    bf16x8 qr[12];
#pragma unroll
    for (int d0 = 0; d0 < 12; ++d0) qr[d0] = *(const bf16x8*)(Qw + d0 * 16);
    const bf16_t* kn = KN + rowbase * 2048 + h * 128; const bf16_t* kp = KPE + rowbase * 64; const bf16_t* vh = V + rowbase * 2048 + h * 128;
    const bf16_t* kps[3]; unsigned kinc[3]; const bf16_t* vps[2];
#pragma unroll
    for (int i = 0; i < 3; ++i) { const int off = 1024 * (wid + 8 * i) + 16 * lane, row = off / 384, cp = off - row * 384, colB = cp ^ (((row >> 1) & 7) << 4), ch = colB >> 4;
        if (ch < 16) { kps[i] = kn + (size_t)row * 2048 + ch * 8; kinc[i] = 64u * 2048u; } else { kps[i] = kp + (size_t)row * 64 + (ch - 16) * 8; kinc[i] = 64u * 64u; } }
#pragma unroll
    for (int i = 0; i < 2; ++i) { const int off = 1024 * (wid + 8 * i) + 16 * lane, sub = off >> 9, within = (off & 511) >> 1, kk = (sub >> 2) * 8 + (within >> 5);
        const int k = (kk & ~0xC) | ((kk & 4) << 1) | ((kk & 8) >> 1), c = (sub & 3) * 32 + (within & 31); vps[i] = vh + (size_t)k * 2048 + c; }
    const int NT = 4 * qb + 4, tvis = 4 * qb + (wid >> 1);
    const int vb0 = (int)(unsigned)(size_t)Vl + v_rd_base(lane);
    constexpr float C = A_SCALE * LOG2E, THRR = 8.f / A_SCALE;
    float m_reg = -1e30f, l_reg = 0.f; f32x16 o[4]; o[0] = f32x16{}; o[1] = f32x16{}; o[2] = f32x16{}; o[3] = f32x16{};
#define MLA_DMA(t, buf) do { _Pragma("unroll") for (int i = 0; i < 3; ++i) __builtin_amdgcn_global_load_lds((const unsigned*)(kps[i] + (size_t)(t) * kinc[i]), (LAS unsigned*)(Kl + (buf) * MLA_KB + 1024 * (wid + 8 * i)), 16, 0, 0); \
    _Pragma("unroll") for (int i = 0; i < 2; ++i) __builtin_amdgcn_global_load_lds((const unsigned*)(vps[i] + (size_t)(t) * (64 * 2048)), (LAS unsigned*)(Vl + (buf) * MLA_VB + 1024 * (wid + 8 * i)), 16, 0, 0); } while (0)
#define MLA_SYNC() do { asm volatile("s_waitcnt vmcnt(0) lgkmcnt(0)" ::: "memory"); __builtin_amdgcn_s_barrier(); asm volatile("" ::: "memory"); } while (0)
    MLA_SYNC();
    MLA_DMA(0, 0); MLA_SYNC();
    for (int t = 0; t < NT; ++t) {
        const int buf = t & 1;
        if (t + 1 < NT) MLA_DMA(t + 1, buf ^ 1);
        if (t <= tvis) {
            f32x16 p0, p1; float alpha; bf16x8 pa0, pa1, pa2, pa3;
            qkt<192>(p0, p1, Kl + buf * MLA_KB, qr, r32, hi);
            partialSM(p0, p1, m_reg, alpha, C, THRR);
            ATT_RESC(4, alpha);
            finishSM(p0, p1, alpha, l_reg, pa0, pa1, pa2, pa3);
            const int vb = vb0 + buf * MLA_VB;
            pv_one<4, 0>(o[0], vb, pa0, pa1, pa2, pa3); pv_one<4, 1>(o[1], vb, pa0, pa1, pa2, pa3); pv_one<4, 2>(o[2], vb, pa0, pa1, pa2, pa3); pv_one<4, 3>(o[3], vb, pa0, pa1, pa2, pa3);
        }
        MLA_SYNC();
    }
#undef MLA_DMA
#undef MLA_SYNC
    if (hi == 0) al_l[r32] = l_reg; asm volatile("s_waitcnt lgkmcnt(0)" ::: "memory");
    bf16_t* Ow = O + (rowbase + q0 + wid * 32) * 2048 + h * 128;
#pragma unroll
    for (int r = 0; r < 16; ++r) { const int orow = crow(r, hi); const float rl = __builtin_amdgcn_rcpf(al_l[orow]);
#pragma unroll
        for (int d0 = 0; d0 < 4; ++d0) Ow[(size_t)orow * 2048 + d0 * 32 + r32] = (bf16_t)f2bf(o[d0][r] * rl); }
}

constexpr int SWA_KB = 64 * 64 * 2, SWA_VB = 64 * 64 * 2;
constexpr int SWA_LDS = 2 * SWA_KB + 2 * SWA_VB + 8 * 256;
__device__ __forceinline__ void swa_unit(LAS unsigned char* lds, const bf16_t* __restrict__ Qb  , const bf16_t* __restrict__ Kb, const bf16_t* __restrict__ Vb  ,
                                         bf16_t* __restrict__ Ob, int NT, bool last_half, int nwaves_q, int wsh, const float* __restrict__ sinks4) {
    const int tid = tid_fresh(), lane = tid & 63, r32 = lane & 31, hi = lane >> 5; const int wid = __builtin_amdgcn_readfirstlane(tid >> 6);
    LAS unsigned char* Kl = lds; LAS unsigned char* Vl = lds + 2 * SWA_KB; LAS float* al_l = (LAS float*)(lds + 2 * SWA_KB + 2 * SWA_VB) + wid * 64;
    const bool qwave = wid < nwaves_q;
    const int g = wid >> wsh, rloc = 32 * (wid & ((1 << wsh) - 1)) + r32;
    bf16x8 qr[4];
    if (qwave) {
#pragma unroll
        for (int d0 = 0; d0 < 4; ++d0) qr[d0] = *(const bf16x8*)(Qb + (size_t)rloc * 2048 + g * 64 + d0 * 16 + hi * 8);
    } else {
#pragma unroll
        for (int d0 = 0; d0 < 4; ++d0) qr[d0] = bf16x8{};
    }
    const int srow = tid >> 3, sch = tid & 7;
    const bf16_t* ksrc = Kb + (size_t)srow * 512 + sch * 8; const bf16_t* vsrc = Vb + (size_t)srow * 512 + sch * 8;
    const int kdst = kswz<128>(srow, sch * 16), vdst = v_st<2>(srow, sch * 8);
    const int vb0 = (int)(unsigned)(size_t)Vl + v_rd_base(lane);
    constexpr float C = B_SCALE * LOG2E, THRR = 8.f / B_SCALE;
    float m_reg = -1e30f, l_reg = 0.f; f32x16 o[2]; o[0] = f32x16{}; o[1] = f32x16{};
    bf16x8 sk, sv;
    __syncthreads();
    sk = *(const bf16x8*)ksrc; sv = *(const bf16x8*)vsrc;
    *(LAS bf16x8*)(Kl + kdst) = sk; *(LAS bf16x8*)(Vl + vdst) = sv; __syncthreads();
    for (int t = 0; t < NT; ++t) {
        const int buf = t & 1;
        if (t + 1 < NT) { sk = *(const bf16x8*)(ksrc + (size_t)(t + 1) * 64 * 512); sv = *(const bf16x8*)(vsrc + (size_t)(t + 1) * 64 * 512); }
        if (qwave) {
            f32x16 p0, p1; float alpha; bf16x8 pa0, pa1, pa2, pa3;
            qkt<64>(p0, p1, Kl + buf * SWA_KB, qr, r32, hi);
            if (last_half && t == NT - 1) {
#pragma unroll
                for (int r = 0; r < 16; ++r) p1[r] = -1e30f;
            }
            partialSM(p0, p1, m_reg, alpha, C, THRR);
            ATT_RESC(2, alpha);
            finishSM(p0, p1, alpha, l_reg, pa0, pa1, pa2, pa3);
            const int vb = vb0 + buf * SWA_VB;
            pv_one<2, 0>(o[0], vb, pa0, pa1, pa2, pa3); pv_one<2, 1>(o[1], vb, pa0, pa1, pa2, pa3);
        }
        if (t + 1 < NT) { *(LAS bf16x8*)(Kl + (buf ^ 1) * SWA_KB + kdst) = sk; *(LAS bf16x8*)(Vl + (buf ^ 1) * SWA_VB + vdst) = sv; }
        __syncthreads();
    }
    if (qwave) {
        const float sk_l = sinks4[g];
        l_reg += __builtin_amdgcn_exp2f((sk_l - m_reg * B_SCALE) * LOG2E);
        if (hi == 0) al_l[r32] = l_reg; asm volatile("s_waitcnt lgkmcnt(0)" ::: "memory");
        const int rbase = 32 * (wid & ((1 << wsh) - 1));
#pragma unroll
        for (int r = 0; r < 16; ++r) { const int orow = crow(r, hi); const float rl = __builtin_amdgcn_rcpf(al_l[orow]);
#pragma unroll
            for (int d0 = 0; d0 < 2; ++d0) Ob[(size_t)(rbase + orow) * 2048 + g * 64 + d0 * 32 + r32] = (bf16_t)f2bf(o[d0][r] * rl); }
    }
}
__device__ __forceinline__ f32x16 wave_gemm_tile(const bf16_t* __restrict__ A, int lda, const bf16_t* __restrict__ Bt, int ldb, int K, int r32, int hi) {
    f32x16 acc = f32x16{};
    const bf16_t* ap = A + (size_t)r32 * lda + hi * 8; const bf16_t* bp = Bt + (size_t)r32 * ldb + hi * 8;
    for (int k0 = 0; k0 < K; k0 += 128) {
        bf16x8 a[8], b[8];
#pragma unroll
        for (int i = 0; i < 8; ++i) { a[i] = *(const bf16x8*)(ap + k0 + 16 * i); b[i] = *(const bf16x8*)(bp + k0 + 16 * i); }
#pragma unroll
        for (int i = 0; i < 8; ++i) acc = __builtin_amdgcn_mfma_f32_32x32x16_bf16(a[i], b[i], acc, 0, 0, 0);
    }
    return acc;
}
#undef SBAR
}

struct Args { const float* in[22]; float* out; unsigned char* ws; int grid; int pad; };
typedef const __attribute__((address_space(4))) Args* KArgs;
__device__ __forceinline__ KArgs kargp() { KArgs p = (KArgs)__builtin_amdgcn_kernarg_segment_ptr(); asm volatile("" : "+s"(p)); return p; }
#define PH_BEGIN KArgs ka = kargp(); unsigned char* const ws = ka->ws; float* const out = ka->out; (void)out; (void)ws; \
    const int G = ka->grid, bx = bx_fresh(), vcu = (G % 8 == 0) ? (bx % 8) * (G / 8) + bx / 8 : bx, NGW = G * NWAVES; (void)NGW; \
    const int tid = tid_fresh(), lane = tid & 63, wave = __builtin_amdgcn_readfirstlane(tid >> 6), gw = vcu * NWAVES + wave; (void)lane; (void)gw
#define IN(k) (ka->in[k])
#define XB_TMO      128
#define XB_XCNT(j)  (256  + 64 * (j))
#define XB_XSUB(j)  (1280 + 64 * (j))
#define XB_XGEN(j)  (2304 + 64 * (j))
#define XB_TOP      3328
#define XB_TOPGEN   3392
#define XCD_BAR_WORDS 3456
#define XB_SPIN_CAP (1u << 18)
__device__ __forceinline__ unsigned xb_ld(unsigned* p)              { return __hip_atomic_load(p, __ATOMIC_RELAXED, __HIP_MEMORY_SCOPE_AGENT); }
__device__ __forceinline__ unsigned xb_add(unsigned* p, unsigned v) { return __hip_atomic_fetch_add(p, v, __ATOMIC_RELAXED, __HIP_MEMORY_SCOPE_AGENT); }
__device__ __forceinline__ unsigned xb_xcc_id() { return (unsigned)__builtin_amdgcn_s_getreg((3 << 11) | 20) & 0xFu; }
#define XB_SPIN(cond, bar) do { unsigned _sp = 0; while (cond) { __builtin_amdgcn_s_sleep(1); \
    if ((++_sp & 255u) == 0u) { if (xb_ld(&(bar)[XB_TMO])) break; if (_sp > XB_SPIN_CAP) { atomicAdd(&(bar)[XB_TMO], 1u); break; } } } } while (0)
struct XcdBarrier { unsigned* bar; unsigned x; volatile LAS unsigned* st; };
__device__ __forceinline__ XcdBarrier xcd_barrier_post(unsigned* bar, volatile LAS unsigned* st) {
    XcdBarrier b; b.bar = bar; b.x = xb_xcc_id(); b.st = st;
    if (threadIdx.x == 0) (void)xb_add(&bar[XB_XCNT(b.x)], 1u);
    return b;
}
__device__ __forceinline__ void xcd_barrier_complete(unsigned* bar, unsigned x, unsigned& nloc, unsigned& nx) {
    const unsigned G = (unsigned)kargp()->grid;
    unsigned sum, cnt, mine, sp = 0u;
    for (;;) {
        sum = 0u; cnt = 0u; mine = 0u;
#pragma unroll
        for (unsigned j = 0; j < 16; ++j) { const unsigned c = xb_ld(&bar[XB_XCNT(j)]); sum += c; cnt += (c > 0u) ? 1u : 0u; mine = (j == x) ? c : mine; }
        if (sum == G) break;
        __builtin_amdgcn_s_sleep(1);
        if ((++sp & 255u) == 0u) { if (xb_ld(&bar[XB_TMO])) break; if (sp > XB_SPIN_CAP) { atomicAdd(&bar[XB_TMO], 1u); break; } }
    }
    nloc = mine > 0u ? mine : 1u; nx = cnt > 0u ? cnt : 1u;
}
__device__ __forceinline__ void xcd_barrier(const XcdBarrier& b) {
    asm volatile("s_waitcnt vmcnt(0)" ::: "memory");
    __syncthreads();
    if (threadIdx.x == 0) {
        unsigned* bar = b.bar;
        __builtin_amdgcn_s_waitcnt(0);
        unsigned nloc = b.st[0], nx = b.st[1];
        if (nloc == 0u) { xcd_barrier_complete(bar, b.x, nloc, nx); b.st[0] = nloc; b.st[1] = nx; }
        const unsigned old = xb_add(&bar[XB_XSUB(b.x)], 1u);
        const unsigned gen = old / nloc;
        if (old + 1u == (gen + 1u) * nloc) {
            __builtin_amdgcn_fence(__ATOMIC_RELEASE, "agent");
            asm volatile("s_waitcnt vmcnt(0)" ::: "memory");
            const unsigned og = xb_add(&bar[XB_TOP], 1u);
            const unsigned tg = og / nx;
            if (og + 1u == (tg + 1u) * nx) xb_add(&bar[XB_TOPGEN], 1u);
            else XB_SPIN(xb_ld(&bar[XB_TOPGEN]) == tg, bar);
            __builtin_amdgcn_fence(__ATOMIC_ACQUIRE, "agent");
            xb_add(&bar[XB_XGEN(b.x)], 1u);
            asm volatile("s_waitcnt vmcnt(0)" ::: "memory");
        } else {
            XB_SPIN(xb_ld(&bar[XB_XGEN(b.x)]) == gen, bar);
            __builtin_amdgcn_fence(__ATOMIC_ACQUIRE, "agent");
            asm volatile("s_waitcnt vmcnt(0)" ::: "memory");
        }
    }
    __syncthreads();
}

template <class Map> __device__ __forceinline__ void p0_transpose_item(const float* __restrict__ W, int ldw, int K, bf16_t* __restrict__ WT, int row_off, int nblk, LAS float* scr, int item, int lane, const Map map, const float* __restrict__ gk = nullptr) {
    const int kb = item / nblk, nb = item - kb * nblk, k0 = 64 * kb, n0 = 32 * nb;
    const int col = map(n0 + (lane & 31));
#pragma unroll 8
    for (int i = 0; i < 32; ++i) { const int kk = 2 * i + (lane >> 5); scr[kk * 33 + (lane & 31)] = col >= 0 ? W[(size_t)(k0 + kk) * ldw + col] * (gk ? gk[k0 + kk] : 1.f) : 0.f; }
    LDS_WAIT(); asm volatile("" ::: "memory");
    const int c = lane & 7;
#pragma unroll
    for (int j = 0; j < 4; ++j) { const int n = (lane >> 3) + 8 * j; const LAS float* s = scr + (8 * c) * 33 + n;
        u32x4 o; o.x = pk2(s[0 * 33], s[1 * 33]); o.y = pk2(s[2 * 33], s[3 * 33]); o.z = pk2(s[4 * 33], s[5 * 33]); o.w = pk2(s[6 * 33], s[7 * 33]);
        *(u32x4*)(WT + (size_t)(row_off + n0 + n) * K + k0 + 8 * c) = o; }
    LDS_WAIT(); asm volatile("" ::: "memory");
}
template <class Map> __device__ __forceinline__ void p0_transpose_item64(const float* __restrict__ W, int ldw, int K, bf16_t* __restrict__ WT, int row_off, int nblk, LAS float* scr, int item, int lane, const Map map, const float* __restrict__ gk = nullptr) {
    const int kb = item / nblk, nb = item - kb * nblk, k0 = 64 * kb, n0 = 64 * nb;
    const int colb = map(n0);
    f32x4 v[16];
#pragma unroll
    for (int i = 0; i < 16; ++i) { const int kk = 4 * i + (lane >> 4); v[i] = colb >= 0 ? *(const f32x4*)(W + (size_t)(k0 + kk) * ldw + colb + 4 * (lane & 15)) : (f32x4){0.f, 0.f, 0.f, 0.f}; }
    if (gk) {
#pragma unroll
        for (int i = 0; i < 16; ++i) v[i] = v[i] * gk[k0 + 4 * i + (lane >> 4)];
    }
#pragma unroll
    for (int i = 0; i < 16; ++i) { LAS float* d = scr + (4 * i + (lane >> 4)) * 65 + 4 * (lane & 15); d[0] = v[i][0]; d[1] = v[i][1]; d[2] = v[i][2]; d[3] = v[i][3]; }
    LDS_WAIT(); asm volatile("" ::: "memory");
    const int c = lane & 7;
#pragma unroll
    for (int j = 0; j < 8; ++j) { const int n = (lane >> 3) + 8 * j; const LAS float* sp = scr + (8 * c) * 65 + n;
        u32x4 o; o.x = pk2(sp[0 * 65], sp[1 * 65]); o.y = pk2(sp[2 * 65], sp[3 * 65]); o.z = pk2(sp[4 * 65], sp[5 * 65]); o.w = pk2(sp[6 * 65], sp[7 * 65]);
        *(u32x4*)(WT + (size_t)(row_off + n0 + n) * K + k0 + 8 * c) = o; }
    LDS_WAIT(); asm volatile("" ::: "memory");
}
struct MapId { int nvalid; __device__ __forceinline__ int operator()(int n) const { return n < nvalid ? n : -1; } };
struct MapQb { __device__ __forceinline__ int operator()(int n) const { const int hd = n / AQK, w = n - hd * AQK; if (w < ANOPE) return n; const int v = w - ANOPE; return hd * AQK + ANOPE + (v & 1) * 32 + (v >> 1); } };
struct MapQkvSwa { __device__ __forceinline__ int operator()(int n) const { if (n >= 2560) return n; const int w = n & 63; if (w >= 16) return n; return (n - w) + (w & 1) * 8 + (w >> 1); } };
struct MapFfn { __device__ __forceinline__ int operator()(int n) const { const int t = n >> 8, w = n & 255; return w < 128 ? t * 128 + w : DFF + t * 128 + (w - 128); } };


__device__ __forceinline__ void norm_phase(int gw, int NGW, int lane, const float* xp, const float* xs, bf16_t* xb, const bf16_t* mb, const float* slabs, int KS, const float* g_post, float* rs, float* y, bool first, bool last) {
    f32x4 gp[4][2];
#pragma unroll
    for (int j = 0; j < 4; ++j) { gp[j][0] = first ? (f32x4){0.f, 0.f, 0.f, 0.f} : ((const f32x4*)g_post)[2 * lane + 128 * j]; gp[j][1] = first ? (f32x4){0.f, 0.f, 0.f, 0.f} : ((const f32x4*)g_post)[2 * lane + 128 * j + 1]; }
    for (int row = gw; row < MALL; row += NGW) {
        f32x4 v[4][2];
        if (first) { const float* xsrc = row < MP ? xp + (size_t)row * DM : xs + (size_t)(row - MP) * DM;
#pragma unroll
            for (int j = 0; j < 4; ++j) { v[j][0] = ((const f32x4*)xsrc)[2 * lane + 128 * j]; v[j][1] = ((const f32x4*)xsrc)[2 * lane + 128 * j + 1]; }
        } else {
            f32x4 mv[4][2]; float ss = 0.f;
#pragma unroll
            for (int j = 0; j < 4; ++j) { const u32x4 w = ((const u32x4*)(xb + (size_t)row * DM))[lane + 64 * j];
                v[j][0] = (f32x4){bf2f(w.x & 0xffffu), bf2f(w.x >> 16), bf2f(w.y & 0xffffu), bf2f(w.y >> 16)}; v[j][1] = (f32x4){bf2f(w.z & 0xffffu), bf2f(w.z >> 16), bf2f(w.w & 0xffffu), bf2f(w.w >> 16)}; }
            if (row < MP) {
#pragma unroll
                for (int j = 0; j < 4; ++j) { const u32x4 w = ((const u32x4*)(mb + (size_t)row * DM))[lane + 64 * j];
                    mv[j][0] = (f32x4){bf2f(w.x & 0xffffu), bf2f(w.x >> 16), bf2f(w.y & 0xffffu), bf2f(w.y >> 16)}; mv[j][1] = (f32x4){bf2f(w.z & 0xffffu), bf2f(w.z >> 16), bf2f(w.w & 0xffffu), bf2f(w.w >> 16)}; }
            } else {
#pragma unroll
                for (int j = 0; j < 4; ++j) { mv[j][0] = (f32x4){0.f, 0.f, 0.f, 0.f}; mv[j][1] = (f32x4){0.f, 0.f, 0.f, 0.f}; }
                for (int sI = 0; sI < KS; ++sI) { const float* sp = slabs + ((size_t)sI * MS + (row - MP)) * DM;
#pragma unroll
                    for (int j = 0; j < 4; ++j) { mv[j][0] += ((const f32x4*)sp)[2 * lane + 128 * j]; mv[j][1] += ((const f32x4*)sp)[2 * lane + 128 * j + 1]; } }
            }
#pragma unroll
            for (int j = 0; j < 4; ++j)
#pragma unroll
                for (int q = 0; q < 2; ++q) ss += (mv[j][q][0] * mv[j][q][0] + mv[j][q][1] * mv[j][q][1]) + (mv[j][q][2] * mv[j][q][2] + mv[j][q][3] * mv[j][q][3]);
            const float rsm = 1.0f / sqrtf(wave_sum(ss, lane) * (1.f / DM) + EPS);
#pragma unroll
            for (int j = 0; j < 4; ++j)
#pragma unroll
                for (int q = 0; q < 2; ++q) v[j][q] = v[j][q] + mv[j][q] * rsm * gp[j][q];
        }
        if (last) {
#pragma unroll
            for (int j = 0; j < 4; ++j) { ((f32x4*)(y + (size_t)row * DM))[2 * lane + 128 * j] = v[j][0]; ((f32x4*)(y + (size_t)row * DM))[2 * lane + 128 * j + 1] = v[j][1]; }
        } else {
            float ss = 0.f;
#pragma unroll
            for (int j = 0; j < 4; ++j) { u32x4 w; w.x = pk2(v[j][0][0], v[j][0][1]); w.y = pk2(v[j][0][2], v[j][0][3]); w.z = pk2(v[j][1][0], v[j][1][1]); w.w = pk2(v[j][1][2], v[j][1][3]);
                ((u32x4*)(xb + (size_t)row * DM))[lane + 64 * j] = w;
                const float r0 = bf2f(w.x & 0xffffu), r1 = bf2f(w.x >> 16), r2 = bf2f(w.y & 0xffffu), r3 = bf2f(w.y >> 16), r4 = bf2f(w.z & 0xffffu), r5 = bf2f(w.z >> 16), r6 = bf2f(w.w & 0xffffu), r7 = bf2f(w.w >> 16);
                ss += ((r0 * r0 + r1 * r1) + (r2 * r2 + r3 * r3)) + ((r4 * r4 + r5 * r5) + (r6 * r6 + r7 * r7)); }
            const float r = 1.0f / sqrtf(wave_sum(ss, lane) * (1.f / DM) + EPS);
            if (lane == 0) rs[row] = r;
        }
    }
}

constexpr int NWAVES = 8;
constexpr int RING_BYTES = 131072, LDS_BYTES = 147456, MISC_OFF = LDS_BYTES - 256;
constexpr int STOP_AFTER = 100000;

__global__ void __launch_bounds__(NWAVES * 64, 2) mega_fwd(Args args) {
    extern __shared__ __attribute__((aligned(16))) unsigned char lds_raw[];
    LAS unsigned char* lds = (LAS unsigned char*)lds_raw;
    volatile LAS unsigned* MISC = (volatile LAS unsigned*)(lds + MISC_OFF);
    for (int u = threadIdx.x; u < (LDS_BYTES - MISC_OFF) / 4; u += NWAVES * 64) ((LAS unsigned*)(lds + MISC_OFF))[u] = 0u;
    __syncthreads();
    { KArgs ka0 = kargp(); (void)xcd_barrier_post((unsigned*)(ka0->ws + WS_CTL) + CW_BAR, MISC + 8); }
    int phase_ctr = 0;
#define GRID_BAR() do { XcdBarrier b_; b_.bar = (unsigned*)(kargp()->ws + WS_CTL) + CW_BAR; b_.x = xb_xcc_id(); b_.st = (volatile LAS unsigned*)(lds + MISC_OFF) + 8; xcd_barrier(b_); \
    if (++phase_ctr >= STOP_AFTER) return; } while (0)
#define ROPEA ((const float*)(ws + WS_ROPEA))
#define ROPEB ((const float*)(ws + WS_ROPEB))
#define XB ((bf16_t*)(ws + WS_R2))
#define MB ((bf16_t*)(ws + WS_R3))
#define SLABS ((float*)(ws + WS_R3 + 132 * MiB))
#define OB ((bf16_t*)(out + O_YP))
#define RSV ((float*)(ws + WS_RS))
#define A_QBUF ((bf16_t*)(ws + WS_R4))
#define A_ABUF ((float*)(ws + WS_R4 + 195 * MiB))
#define A_KN ((bf16_t*)(ws + WS_R4 + 195 * MiB))
#define A_VV ((bf16_t*)(ws + WS_R3))
#define A_CQ ((bf16_t*)(ws + WS_R3 + 128 * MiB))
#define A_CKVB ((bf16_t*)(ws + WS_R3 + 161 * MiB))
#define A_KPEB ((bf16_t*)(ws + WS_R3 + 194 * MiB))
#define A_OLATS ((float*)(ws + WS_R3 + 210 * MiB))
#define A_QA ((bf16_t*)(ws + WS_R3 + 210 * MiB))
#define A_CACHEK ((bf16_t*)(out + O_YP) + (size_t)MALL * DM)
#define A_CACHEVT ((bf16_t*)(ws + WS_R5))
#define A_S ((float*)(ws + WS_R5 + 66 * MiB))
#define A_WB (ws + W_MLA + (size_t)a2 * W_MLA_STRIDE)
#define B_QBUF ((bf16_t*)(ws + WS_R4))
#define B_KBUF ((bf16_t*)(ws + WS_R4 + 130 * MiB))
#define B_VBUF ((bf16_t*)(ws + WS_R4 + 163 * MiB))
#define B_KSAMP ((bf16_t*)(ws + WS_R5))
#define B_VSAMP ((bf16_t*)(ws + WS_R5 + 3 * MiB))
#define B_WB (ws + W_SWA + (size_t)a2 * W_SWA_STRIDE)
#define F_ACT ((bf16_t*)(ws + WS_R4))
#define F_GH ((float*)(ws + WS_R5))
#define F_UH ((float*)(ws + WS_R5 + 45 * MiB))
#define F_GS ((float*)(ws + WS_R5 + 68 * MiB))
#define F_US ((float*)(ws + WS_R5 + 90 * MiB))
#define F_WB (ws + W_FFN + (size_t)L * W_FFN_STRIDE)

    {
        PH_BEGIN;
        LAS float* scr = (LAS float*)(lds + wave * 16896);
        static_assert(8 * 16896 <= MISC_OFF, "P0 scratch");
        constexpr int C_FIN = 32 * (DFF2 / 64), C_FDN = (DFF / 64) * (DM / 64), C_F = C_FIN + C_FDN;
        constexpr int C_AIN = 32 * (AINP / 64), C_AQB = (QL / 64) * (AQB / 32), C_AKV = (KVL / 64) * (2048 / 64), C_AO = 32 * 32, C_UKN = 512, C_A = C_AIN + C_AQB + 2 * C_AKV + C_AO + C_UKN;
        constexpr int C_BQKV = 32 * (BQKV / 32), C_BO = 32 * 32, C_B = C_BQKV + C_BO;
        constexpr int C_RA = 4096, C_RB = 1024;
        constexpr int NITEMS = 4 * C_F + 2 * C_A + 2 * C_B + C_RA + C_RB;
        for (int it = gw; it < NITEMS; it += NGW) {
            int r = it;
            if (r < 4 * C_F) { const int L = r / C_F; r -= L * C_F; unsigned char* wb = ws + W_FFN + (size_t)L * W_FFN_STRIDE;
                if (r < C_FIN) p0_transpose_item64(IN(18) + (size_t)L * DM * DFF2, DFF2, DM, (bf16_t*)wb, 0, DFF2 / 64, scr, r, lane, MapFfn{}, IN(7) + ((size_t)L * 4 + 2) * DM);
                else p0_transpose_item64(IN(21) + (size_t)L * DFF * DM, DM, DFF, (bf16_t*)(wb + 44 * MiB), 0, DM / 64, scr, r - C_FIN, lane, MapId{DM});
                continue; }
            r -= 4 * C_F;
            if (r < 2 * C_A) { const int a = r / C_A; r -= a * C_A; unsigned char* wb = ws + W_MLA + (size_t)a * W_MLA_STRIDE;
                if (r < C_AIN) { p0_transpose_item64(IN(8) + (size_t)a * DM * AIN, AIN, DM, (bf16_t*)wb, 0, AINP / 64, scr, r, lane, MapId{AIN}, IN(7) + ((size_t)(2 * a) * 4) * DM); continue; } r -= C_AIN;
                if (r < C_AQB) { p0_transpose_item(IN(10) + (size_t)a * QL * AQB, AQB, QL, (bf16_t*)(wb + 5 * MiB), 0, AQB / 32, scr, r, lane, MapQb{}); continue; } r -= C_AQB;
                if (r < C_AKV) { p0_transpose_item64(IN(12) + (size_t)a * KVL * 2048, 2048, KVL, (bf16_t*)(wb + 8 * MiB), 0, 32, scr, r, lane, MapId{2048}); continue; } r -= C_AKV;
                if (r < C_AKV) { p0_transpose_item64(IN(13) + (size_t)a * KVL * 2048, 2048, KVL, (bf16_t*)(wb + 8 * MiB), 2048, 32, scr, r, lane, MapId{2048}); continue; } r -= C_AKV;
                if (r < C_AO) { p0_transpose_item64(IN(14) + (size_t)a * DM * DM, DM, DM, (bf16_t*)(wb + 14 * MiB), 0, 32, scr, r, lane, MapId{DM}); continue; } r -= C_AO;
                { const float* src = IN(12) + (size_t)a * KVL * 2048 + (size_t)r * 2048; bf16_t* dst = (bf16_t*)(wb + 12 * MiB) + (size_t)r * 2048;
#pragma unroll
                  for (int j = 0; j < 8; ++j) { const f32x4 t = ((const f32x4*)src)[lane + 64 * j]; u32x2 w; w.x = pk2(t[0], t[1]); w.y = pk2(t[2], t[3]); ((u32x2*)dst)[lane + 64 * j] = w; } }
                continue; }
            r -= 2 * C_A;
            if (r < 2 * C_B) { const int j = r / C_B; r -= j * C_B; unsigned char* wb = ws + W_SWA + (size_t)j * W_SWA_STRIDE;
                if (r < C_BQKV) p0_transpose_item(IN(15) + (size_t)j * DM * BQKV, BQKV, DM, (bf16_t*)wb, 0, BQKV / 32, scr, r, lane, MapQkvSwa{}, IN(7) + ((size_t)(2 * j + 1) * 4) * DM);
                else p0_transpose_item64(IN(17) + (size_t)j * DM * DM, DM, DM, (bf16_t*)(wb + 12 * MiB), 0, 32, scr, r - C_BQKV, lane, MapId{DM});
                continue; }
            r -= 2 * C_B;
            if (r < C_RA) { const int pos = 2 * r + (lane >> 5), i = lane & 31; const double inv = exp2(-(double)i * (1.0 / 32.0) * 18.931568569324174); const double ang = (double)pos * inv;
                float* d = (float*)(ws + WS_ROPEA) + ((size_t)pos * 32 + i) * 2; d[0] = (float)cos(ang); d[1] = (float)sin(ang); continue; }
            r -= C_RA;
            { const int pos = 8 * r + (lane >> 3), i = lane & 7; const double inv = exp2(-(double)i * (1.0 / 8.0) * 18.931568569324174); const double ang = (double)pos * inv;
              float* d = (float*)(ws + WS_ROPEB) + ((size_t)pos * 8 + i) * 2; d[0] = (float)cos(ang); d[1] = (float)sin(ang); }
        }
        norm_phase(gw, NGW, lane, IN(0), IN(1), XB, nullptr, nullptr, 0, nullptr, RSV, nullptr, true, false);
    }
    GRID_BAR();

    for (int L = 0; L < DEPTH; ++L) {
        const int a2 = L >> 1;
        if ((L & 1) == 0) {
            { PH_BEGIN; pg8::Gemm g{XB, (const bf16_t*)A_WB, DM, DM, DM, 0, 0}; pg8::StaticOrder S; S.init(MALL, AINP, G, bx); pg8::EpiF32<true> E{A_ABUF, AINP, 0, RSV};
              pg8::gemm_phase<pg8::EpiF32<true>, pg8::StaticOrder, true>(lds, g, S, E); }
            GRID_BAR();
            {
                PH_BEGIN;
                const float* gq = IN(9) + (size_t)a2 * QL; const float* gkv = IN(11) + (size_t)a2 * KVL;
                const float* abuf = A_ABUF; bf16_t* cqb = A_CQ; bf16_t* ckvb = A_CKVB; bf16_t* kpeb = A_KPEB; const float* ropeA = ROPEA;
                f32x4 gqv[2], gkvv[2];
#pragma unroll
                for (int j = 0; j < 2; ++j) { gqv[j] = ((const f32x4*)gq)[lane + 64 * j]; gkvv[j] = ((const f32x4*)gkv)[lane + 64 * j]; }
                for (int row = gw; row < MALL; row += NGW) {
                    const float* ar = abuf + (size_t)row * AINP;
                    f32x4 c[2], k[2]; float ssq = 0.f, ssk = 0.f;
#pragma unroll
                    for (int j = 0; j < 2; ++j) { c[j] = ((const f32x4*)ar)[lane + 64 * j]; k[j] = ((const f32x4*)(ar + 512))[lane + 64 * j];
                        ssq += (c[j][0] * c[j][0] + c[j][1] * c[j][1]) + (c[j][2] * c[j][2] + c[j][3] * c[j][3]); ssk += (k[j][0] * k[j][0] + k[j][1] * k[j][1]) + (k[j][2] * k[j][2] + k[j][3] * k[j][3]); }
                    const float pe = ar[1024 + lane];
                    const float rq = 1.0f / sqrtf(wave_sum(ssq, lane) * (1.f / QL) + EPS), rk = 1.0f / sqrtf(wave_sum(ssk, lane) * (1.f / KVL) + EPS);
                    float* ckv_out = row < MP ? out + O_CKVP + ((size_t)a2 * MP + row) * KVL : out + O_CKVS + ((size_t)a2 * MS + (row - MP)) * KVL;
                    float* kpe_out = row < MP ? out + O_KPEP + ((size_t)a2 * MP + row) * AROPE : out + O_KPES + ((size_t)a2 * MS + (row - MP)) * AROPE;
#pragma unroll
                    for (int j = 0; j < 2; ++j) { const f32x4 tq = c[j] * rq * gqv[j], tk = k[j] * rk * gkvv[j];
                        u32x2 w; w.x = pk2(tq[0], tq[1]); w.y = pk2(tq[2], tq[3]); ((u32x2*)(cqb + (size_t)row * QL))[lane + 64 * j] = w;
                        ((f32x4*)ckv_out)[lane + 64 * j] = tk;
                        u32x2 w2; w2.x = pk2(tk[0], tk[1]); w2.y = pk2(tk[2], tk[3]); ((u32x2*)(ckvb + (size_t)row * KVL))[lane + 64 * j] = w2; }
                    const float other = lane_xor(pe, lane, 32); const int i = lane & 31; const int pos = row_pos(row);
                    const float cs = ropeA[((size_t)pos * 32 + i) * 2], sn = ropeA[((size_t)pos * 32 + i) * 2 + 1];
                    const float rot = lane < 32 ? pe * cs - other * sn : other * sn + pe * cs;
                    kpe_out[lane] = rot;
                    kpeb[(size_t)row * 64 + 2 * i + (lane >> 5)] = (bf16_t)f2bf(rot);
                }
            }
            GRID_BAR();
            { PH_BEGIN; pg8::Gemm g{A_CQ, (const bf16_t*)(A_WB + 5 * MiB), QL, QL, QL, 0, 0}; pg8::StaticOrder S; S.init(MALL, AQB, G, bx); pg8::EpiQMla E{A_QBUF, ROPEA};
              pg8::gemm_phase<pg8::EpiQMla, pg8::StaticOrder, true>(lds, g, S, E); }
            {
                PH_BEGIN;
                LAS float* scr = (LAS float*)(lds + wave * 16384);
                const float* cckv = IN(2) + (size_t)a2 * NBS * PAST * KVL; const float* ckpe = IN(3) + (size_t)a2 * NBS * PAST * AROPE;
                bf16_t* cacheK = A_CACHEK; bf16_t* cacheVt = A_CACHEVT; const bf16_t* ckvb = A_CKVB; const bf16_t* kpeb = A_KPEB;
                for (int rr = gw; rr < NBS * SKN; rr += NGW) {
                    const int b = rr / SKN, j = rr - b * SKN; bf16_t* dst = cacheK + (size_t)rr * QAK;
                    u32x4 w = (u32x4){0u, 0u, 0u, 0u}; unsigned pe = 0u;
                    if (j < PAST) { const float* src = cckv + ((size_t)b * PAST + j) * KVL; const f32x4 t0 = ((const f32x4*)src)[2 * lane], t1 = ((const f32x4*)src)[2 * lane + 1];
                        w.x = pk2(t0[0], t0[1]); w.y = pk2(t0[2], t0[3]); w.z = pk2(t1[0], t1[1]); w.w = pk2(t1[2], t1[3]);
                        pe = f2bf(ckpe[((size_t)b * PAST + j) * AROPE + (lane & 1) * 32 + (lane >> 1)]); }
                    else if (j < SKEYS) { const size_t tok = (size_t)MP + b * SSEQ + (j - PAST); w = ((const u32x4*)(ckvb + tok * KVL))[lane]; pe = kpeb[tok * 64 + lane]; }
                    ((u32x4*)dst)[lane] = w; dst[512 + lane] = (bf16_t)pe; dst[576 + lane] = 0;
                }
                for (int it = gw; it < NBS * 66 * 16; it += NGW) {
                    const int b = it / (66 * 16), r2 = it - b * (66 * 16), kb = r2 >> 4, rb = r2 & 15;
#pragma unroll 8
                    for (int i = 0; i < 32; ++i) { const int kk = 2 * i + (lane >> 5), j = 64 * kb + kk, rr = 32 * rb + (lane & 31); float v = 0.f;
                        if (j < PAST) v = cckv[((size_t)b * PAST + j) * KVL + rr]; else if (j < SKEYS) v = bf2f(ckvb[((size_t)MP + b * SSEQ + (j - PAST)) * KVL + rr]);
                        scr[kk * 33 + (lane & 31)] = v; }
                    LDS_WAIT(); asm volatile("" ::: "memory");
                    const int c = lane & 7;
#pragma unroll
                    for (int jj = 0; jj < 4; ++jj) { const int n = (lane >> 3) + 8 * jj; const LAS float* s = scr + (8 * c) * 33 + n;
                        u32x4 o; o.x = pk2(s[0 * 33], s[1 * 33]); o.y = pk2(s[2 * 33], s[3 * 33]); o.z = pk2(s[4 * 33], s[5 * 33]); o.w = pk2(s[6 * 33], s[7 * 33]);
                        *(u32x4*)(cacheVt + ((size_t)b * KVL + 32 * rb + n) * SKK + 64 * kb + 8 * c) = o; }
                    LDS_WAIT(); asm volatile("" ::: "memory");
                }
            }
            GRID_BAR();
            { PH_BEGIN; bf16_t* knbuf = A_KN; bf16_t* vvbuf = A_VV;
              pg8::Gemm g{A_CKVB, (const bf16_t*)(A_WB + 8 * MiB), KVL, KVL, KVL, 0, 0}; pg8::StaticOrder S; S.init(MP, 4096, G, bx); pg8::EpiBf16 E{knbuf, 2048, 2048, (ptrdiff_t)(vvbuf - knbuf), 0};
              pg8::gemm_phase<pg8::EpiBf16, pg8::StaticOrder, true>(lds, g, S, E); }
            {
                PH_BEGIN;
                const bf16_t* qbuf = A_QBUF; const bf16_t* w_uk_nat = (const bf16_t*)(A_WB + 12 * MiB); bf16_t* qA = A_QA;
                const int r32 = lane & 31, hi = lane >> 5;
                for (int it = gw; it < 16 * 16 * 16; it += NGW) { const int tt = it >> 8, h = (it >> 4) & 15, nt = it & 15;
                    const f32x16 acc = att::wave_gemm_tile(qbuf + ((size_t)MP + 32 * tt) * AQB + h * AQK, AQB, w_uk_nat + (size_t)(32 * nt) * 2048 + h * 128, 2048, ANOPE, r32, hi);
#pragma unroll
                    for (int r = 0; r < 16; ++r) { const int tok = 32 * tt + att::crow(r, hi); qA[((size_t)tok * 16 + h) * QAK + 32 * nt + r32] = (bf16_t)f2bf(acc[r]); } }
                for (int it = gw; it < MS * 16 / 4; it += NGW) { const int row = it * 4 + (lane >> 4), l16 = lane & 15, tok = row >> 4, h = row & 15;
                    u32x4 w = (u32x4){0u, 0u, 0u, 0u}; if (l16 < 8) w = *(const u32x4*)(qbuf + ((size_t)MP + tok) * AQB + h * AQK + ANOPE + l16 * 8);
                    *(u32x4*)(qA + (size_t)row * QAK + 512 + l16 * 8) = w; }
            }
            GRID_BAR();
            { PH_BEGIN; pg8::Gemm g{A_QA, A_CACHEK, QAK, QAK, QAK, (size_t)512 * QAK, (size_t)SKN * QAK}; pg8::BatchOrder S{2, SKN / 256, NBS, G, bx}; pg8::EpiF32<false> E{A_S, SKN, (size_t)512 * SKN, nullptr};
              pg8::gemm_phase<pg8::EpiF32<false>, pg8::BatchOrder, true>(lds, g, S, E); }
            GRID_BAR();
            {
                PH_BEGIN;
                float* Sbuf = A_S;
                constexpr float C = A_SCALE * LOG2E;
                for (int rr = gw; rr < NBS * 512; rr += NGW) {
                    const float* sr = Sbuf + (size_t)rr * SKN; f32x4 v[17]; float mx = -3.0e38f;
#pragma unroll
                    for (int j = 0; j < 17; ++j) { v[j] = ((const f32x4*)sr)[lane + 64 * j]; const int c0 = 4 * lane + 256 * j;
#pragma unroll
                        for (int e = 0; e < 4; ++e) { if (c0 + e >= SKEYS) v[j][e] = -3.0e38f; mx = fmaxf(mx, v[j][e]); } }
                    mx = wave_max(mx, lane); float sum = 0.f; const float mC = mx * C;
#pragma unroll
                    for (int j = 0; j < 17; ++j) {
#pragma unroll
                        for (int e = 0; e < 4; ++e) { const float p = (4 * lane + 256 * j + e < SKEYS) ? __builtin_amdgcn_exp2f(fmaf(v[j][e], C, -mC)) : 0.f; v[j][e] = p; sum += p; } }
                    const float rinv = 1.0f / wave_sum(sum, lane);
                    asm volatile("" ::: "memory");
                    bf16_t* pr = (bf16_t*)sr;
#pragma unroll
                    for (int j = 0; j < 17; ++j) { const int c0 = 4 * lane + 256 * j; if (c0 < SKK) { u32x2 w; w.x = pk2(v[j][0] * rinv, v[j][1] * rinv); w.y = pk2(v[j][2] * rinv, v[j][3] * rinv); *(u32x2*)(pr + c0) = w; } }
                }
            }
            GRID_BAR();
            { PH_BEGIN; pg8::Gemm g{(const bf16_t*)A_S, A_CACHEVT, SKK / 3, SPITCH, SKK, (size_t)512 * SPITCH, (size_t)KVL * SKK, (size_t)(SKK / 3)}; pg8::BatchSplitOrder S{2, 2, NBS, 3, G, bx};
              pg8::EpiF32<false> E{A_OLATS, KVL, (size_t)512 * KVL, nullptr, (size_t)NBS * 512 * KVL};
              pg8::gemm_phase<pg8::EpiF32<false>, pg8::BatchSplitOrder, true>(lds, g, S, E); }
            GRID_BAR();
            {
                PH_BEGIN;
                const float* olats = A_OLATS; const bf16_t* w_kv_t = (const bf16_t*)(A_WB + 8 * MiB); bf16_t* hbuf = OB;
                const int r32 = lane & 31, hi = lane >> 5; constexpr size_t SLB = (size_t)NBS * 512 * KVL;
                for (int it = gw; it < 16 * 16 * 4; it += NGW) { const int tt = it >> 6, h = (it >> 2) & 15, vt = it & 3;
                    const float* ap = olats + ((size_t)(32 * tt + r32) * 16 + h) * KVL + hi * 8; const bf16_t* bp = w_kv_t + (size_t)(2048 + h * 128 + 32 * vt + r32) * KVL + hi * 8;
                    f32x16 acc = f32x16{};
                    for (int k0 = 0; k0 < KVL; k0 += 64) {
                        f32x4 x[4][2]; bf16x8 bq[4];
#pragma unroll
                        for (int i = 0; i < 4; ++i) { x[i][0] = *(const f32x4*)(ap + k0 + 16 * i); x[i][1] = *(const f32x4*)(ap + k0 + 16 * i + 4); bq[i] = *(const bf16x8*)(bp + k0 + 16 * i); }
#pragma unroll
                        for (int sI = 1; sI < 3; ++sI)
#pragma unroll
                            for (int i = 0; i < 4; ++i) { x[i][0] += *(const f32x4*)(ap + sI * SLB + k0 + 16 * i); x[i][1] += *(const f32x4*)(ap + sI * SLB + k0 + 16 * i + 4); }
#pragma unroll
                        for (int i = 0; i < 4; ++i) { u32x4 w; w.x = cvt_pk_bf16(x[i][0][0], x[i][0][1]); w.y = cvt_pk_bf16(x[i][0][2], x[i][0][3]); w.z = cvt_pk_bf16(x[i][1][0], x[i][1][1]); w.w = cvt_pk_bf16(x[i][1][2], x[i][1][3]);
                            acc = __builtin_amdgcn_mfma_f32_32x32x16_bf16(__builtin_bit_cast(bf16x8, w), bq[i], acc, 0, 0, 0); }
                    }
#pragma unroll
                    for (int r = 0; r < 16; ++r) { const int tok = 32 * tt + att::crow(r, hi); hbuf[((size_t)MP + tok) * DM + h * 128 + 32 * vt + r32] = (bf16_t)f2bf(acc[r]); } }
            }
            {
                PH_BEGIN;
                for (int p = vcu; p < NBP * AH * 16; p += G) { const int bh = p >> 4, s = p & 15;
                    att::mla_unit(lds, bh >> 4, bh & 15, s, A_QBUF, A_KN, A_KPEB, A_VV, OB);
                    att::mla_unit(lds, bh >> 4, bh & 15, 31 - s, A_QBUF, A_KN, A_KPEB, A_VV, OB); }
            }
            GRID_BAR();
        } else {
            { PH_BEGIN;
              float* wkp = out + O_WKP + (size_t)a2 * NBP * WIN * 512; float* wvp = out + O_WVP + (size_t)a2 * NBP * WIN * 512;
              float* wks = out + O_WKS + (size_t)a2 * NBS * WIN * 512; float* wvs = out + O_WVS + (size_t)a2 * NBS * WIN * 512;
              pg8::Gemm g{XB, (const bf16_t*)B_WB, DM, DM, DM, 0, 0}; pg8::StaticOrder S; S.init(MALL, BQKV, G, bx); pg8::EpiQkvSwa E{B_QBUF, B_KBUF, B_VBUF, B_KSAMP, B_VSAMP, ROPEB, wkp, wvp, wks, wvs, RSV};
              pg8::gemm_phase<pg8::EpiQkvSwa, pg8::StaticOrder, true>(lds, g, S, E); }
            {
                PH_BEGIN;
                float* wks = out + O_WKS + (size_t)a2 * NBS * WIN * 512; float* wvs = out + O_WVS + (size_t)a2 * NBS * WIN * 512;
                bf16_t* ksamp = B_KSAMP; bf16_t* vsamp = B_VSAMP;
                const float* pk = IN(4) + (size_t)a2 * NBS * WIN * 512; const float* pv = IN(5) + (size_t)a2 * NBS * WIN * 512;
                for (int rr = gw; rr < NBS * 192; rr += NGW) { const int b = rr / 192, j = rr - b * 192;
                    if (j >= 128 && j < 160) continue;
                    bf16_t* kd = ksamp + (size_t)rr * 512; bf16_t* vd = vsamp + (size_t)rr * 512;
                    if (j < 128) { const float* ks = pk + ((size_t)b * WIN + j) * 512; const float* vs = pv + ((size_t)b * WIN + j) * 512;
                        const f32x4 k0 = ((const f32x4*)ks)[2 * lane], k1 = ((const f32x4*)ks)[2 * lane + 1], v0 = ((const f32x4*)vs)[2 * lane], v1 = ((const f32x4*)vs)[2 * lane + 1];
                        u32x4 w; w.x = pk2(v0[0], v0[1]); w.y = pk2(v0[2], v0[3]); w.z = pk2(v1[0], v1[1]); w.w = pk2(v1[2], v1[3]); ((u32x4*)vd)[lane] = w;
                        const int c0 = 8 * lane, wq = c0 & 63;
                        if (wq < 16) {
#pragma unroll
                            for (int e = 0; e < 8; ++e) { const int vv = wq + e; kd[c0 - wq + vv] = (bf16_t)f2bf(ks[c0 - wq + (vv & 1) * 8 + (vv >> 1)]); }
                        } else { u32x4 wk; wk.x = pk2(k0[0], k0[1]); wk.y = pk2(k0[2], k0[3]); wk.z = pk2(k1[0], k1[1]); wk.w = pk2(k1[2], k1[3]); ((u32x4*)kd)[lane] = wk; }
                        if (j >= 32) { float* ko = wks + ((size_t)b * WIN + (j - 32)) * 512; float* vo = wvs + ((size_t)b * WIN + (j - 32)) * 512;
                            ((f32x4*)ko)[2 * lane] = k0; ((f32x4*)ko)[2 * lane + 1] = k1; ((f32x4*)vo)[2 * lane] = v0; ((f32x4*)vo)[2 * lane + 1] = v1; }
                    } else { ((u32x4*)kd)[lane] = (u32x4){0u, 0u, 0u, 0u}; ((u32x4*)vd)[lane] = (u32x4){0u, 0u, 0u, 0u}; }
                }
            }
            GRID_BAR();
            {
                PH_BEGIN;
                const float* sinks = IN(16) + (size_t)a2 * BH;
                const bf16_t* qbuf = B_QBUF; const bf16_t* kbuf = B_KBUF; const bf16_t* vbuf = B_VBUF; const bf16_t* ksamp = B_KSAMP; const bf16_t* vsamp = B_VSAMP; bf16_t* hbuf = OB;
                for (int it = vcu; it < NBP * 128 * BKVH + NBS * BKVH; it += G) {
                    if (it < NBP * 128 * BKVH) { const int kvh = it & 7, c = (it >> 3) & 127, b = it >> 10; const int cs = c >= 2 ? c - 2 : 0;
                        att::swa_unit(lds, qbuf + ((size_t)b * SEQ + 64 * c) * 2048 + kvh * 256, kbuf + ((size_t)b * SEQ + 64 * cs) * 512 + kvh * 64, vbuf + ((size_t)b * SEQ + 64 * cs) * 512 + kvh * 64,
                                      hbuf + ((size_t)b * SEQ + 64 * c) * 2048 + kvh * 256, c - cs + 1, false, 8, 1, sinks + kvh * 4);
                    } else { const int r = it - NBP * 128 * BKVH, kvh = r & 7, b = r >> 3;
                        att::swa_unit(lds, qbuf + ((size_t)MP + b * SSEQ) * 2048 + kvh * 256, ksamp + (size_t)b * 192 * 512 + kvh * 64, vsamp + (size_t)b * 192 * 512 + kvh * 64,
                                      hbuf + ((size_t)MP + b * SSEQ) * 2048 + kvh * 256, 3, true, 4, 0, sinks + kvh * 4); }
                }
            }
            GRID_BAR();
        }
        { PH_BEGIN; const bf16_t* w_o_t = (L & 1) ? (const bf16_t*)(B_WB + 12 * MiB) : (const bf16_t*)(A_WB + 14 * MiB);
          { pg8::Gemm g{OB, w_o_t, DM, DM, DM, 0, 0}; pg8::StaticOrder S; S.init(MP, DM, G, bx); pg8::EpiBf16 E{MB, DM, 0, 0, 0};
            pg8::gemm_phase<pg8::EpiBf16, pg8::StaticOrder, true>(lds, g, S, E); }
          { pg8::Gemm g{OB + (size_t)MP * DM, w_o_t, 256, DM, DM, 256, 256}; pg8::BatchOrder S{2, 8, 8, G, bx}; pg8::EpiF32<false> E{SLABS, DM, (size_t)MS * DM, nullptr};
            pg8::gemm_phase<pg8::EpiF32<false>, pg8::BatchOrder, true>(lds, g, S, E); } }
        GRID_BAR();
        { PH_BEGIN; const float* gL = IN(7) + (size_t)L * 4 * DM; norm_phase(gw, NGW, lane, nullptr, nullptr, XB, MB, SLABS, 8, gL + DM, RSV, nullptr, false, false); }
        GRID_BAR();
        { PH_BEGIN;
          { pg8::Gemm g{XB, (const bf16_t*)F_WB, DM, DM, DM, 0, 0}; pg8::StaticOrder S; S.init(MP, DFF2, G, bx);
            pg8::EpiFfn E{F_ACT, IN(19) + (size_t)L * 3 * DFF, IN(20) + (size_t)L * DFF, F_GH, F_UH, RSV};
            pg8::gemm_phase<pg8::EpiFfn, pg8::StaticOrder, true>(lds, g, S, E); }
          { pg8::Gemm g{XB + (size_t)MP * DM, (const bf16_t*)F_WB, 1024, DM, DM, 1024, 1024}; pg8::BatchOrder S{2, DFF2 / 256, 2, G, bx}; pg8::EpiFfnS E{F_GS, F_US, RSV};
            pg8::gemm_phase<pg8::EpiFfnS, pg8::BatchOrder, true>(lds, g, S, E); } }
        GRID_BAR();
        {
            PH_BEGIN;
            const float* st = IN(6) + (size_t)L * NBS * 2 * DFF; const float* cw = IN(19) + (size_t)L * 3 * DFF; const float* cb = IN(20) + (size_t)L * DFF;
            bf16_t* act = F_ACT; const float* Gh = F_GH; const float* Uh = F_UH; const float* Gs = F_GS; const float* Us = F_US;
            constexpr size_t SL = (size_t)MS * DFF;
            for (int it = gw; it < 1024 + MS + 8 + 32; it += NGW) {
                if (it < 1024 + MS) {
                    const float *cur, *upv, *p1 = nullptr, *p2 = nullptr; bool c2 = false, p1s = false, p2s = false; size_t R;
                    if (it < 1024) { const int blk = it >> 1, j = it & 1; R = (size_t)64 * blk + j; const int t = (int)(R & (SEQ - 1));
                        cur = Gh + ((size_t)blk * 4 + 2 + j) * DFF; upv = Uh + ((size_t)blk * 2 + j) * DFF;
                        if (j == 0) { if (t > 0) { p1 = Gh + ((size_t)(blk - 1) * 4 + 1) * DFF; p2 = Gh + ((size_t)(blk - 1) * 4 + 0) * DFF; } }
                        else { p1 = Gh + ((size_t)blk * 4 + 2) * DFF; if (t > 1) p2 = Gh + ((size_t)(blk - 1) * 4 + 1) * DFF; }
                    } else { const int rs_ = it - 1024, b = rs_ >> 5, t = rs_ & 31; R = (size_t)MP + rs_; cur = Gs + (size_t)rs_ * DFF; upv = Us + (size_t)rs_ * DFF; c2 = true;
                        if (t >= 1) { p1 = Gs + (size_t)(rs_ - 1) * DFF; p1s = true; } else p1 = st + ((size_t)b * 2 + 1) * DFF;
                        if (t >= 2) { p2 = Gs + (size_t)(rs_ - 2) * DFF; p2s = true; } else p2 = st + ((size_t)b * 2 + t) * DFF; }
                    for (int c0 = 4 * lane; c0 < DFF; c0 += 256) {
                        f32x4 g0 = *(const f32x4*)(cur + c0), u0 = *(const f32x4*)(upv + c0);
                        if (c2) { g0 += *(const f32x4*)(cur + SL + c0); u0 += *(const f32x4*)(upv + SL + c0); }
                        f32x4 a1 = p1 ? *(const f32x4*)(p1 + c0) : (f32x4){0.f, 0.f, 0.f, 0.f}, a2v = p2 ? *(const f32x4*)(p2 + c0) : (f32x4){0.f, 0.f, 0.f, 0.f};
                        if (p1s) a1 += *(const f32x4*)(p1 + SL + c0);
                        if (p2s) a2v += *(const f32x4*)(p2 + SL + c0);
                        const f32x4 w0 = *(const f32x4*)(cw + c0), w1 = *(const f32x4*)(cw + DFF + c0), w2 = *(const f32x4*)(cw + 2 * DFF + c0), bb = *(const f32x4*)(cb + c0);
                        const f32x4 cv = bb + w0 * a2v + w1 * a1 + w2 * g0; f32x4 a;
#pragma unroll
                        for (int e = 0; e < 4; ++e) a[e] = cv[e] / (1.f + __expf(-cv[e])) * u0[e];
                        u32x2 w; w.x = pk2(a[0], a[1]); w.y = pk2(a[2], a[3]); *(u32x2*)(act + R * DFF + c0) = w; }
                } else if (it < 1024 + MS + 8) { const int q = it - (1024 + MS), b = q >> 1, j = q & 1;
                    const float* src = Gh + ((size_t)(b * 128 + 127) * 4 + j) * DFF; float* dst = out + O_FCP + (((size_t)L * NBP + b) * 2 + j) * DFF;
                    for (int c0 = 4 * lane; c0 < DFF; c0 += 256) *(f32x4*)(dst + c0) = *(const f32x4*)(src + c0);
                } else { const int q = it - (1024 + MS + 8), b = q >> 1, j = q & 1;
                    const float* src = Gs + (size_t)(b * SSEQ + 30 + j) * DFF; float* dst = out + O_FCS + (((size_t)L * NBS + b) * 2 + j) * DFF;
                    for (int c0 = 4 * lane; c0 < DFF; c0 += 256) *(f32x4*)(dst + c0) = *(const f32x4*)(src + c0) + *(const f32x4*)(src + SL + c0); }
            }
        }
        GRID_BAR();
        { PH_BEGIN; const bf16_t* w_dn_t = (const bf16_t*)(F_WB + 44 * MiB);
          { pg8::Gemm g{F_ACT, w_dn_t, DFF, DFF, DFF, 0, 0}; pg8::StaticOrder S; S.init(MP, DM, G, bx); pg8::EpiBf16 E{MB, DM, 0, 0, 0};
            pg8::gemm_phase<pg8::EpiBf16, pg8::StaticOrder, true>(lds, g, S, E); }
          { pg8::Gemm g{F_ACT + (size_t)MP * DFF, w_dn_t, 512, DFF, DFF, 512, 512}; pg8::BatchOrder S{2, 8, 11, G, bx}; pg8::EpiF32<false> E{SLABS, DM, (size_t)MS * DM, nullptr};
            pg8::gemm_phase<pg8::EpiF32<false>, pg8::BatchOrder, true>(lds, g, S, E); } }
        GRID_BAR();
        { PH_BEGIN; const float* gL = IN(7) + (size_t)L * 4 * DM; norm_phase(gw, NGW, lane, nullptr, nullptr, XB, MB, SLABS, 11, gL + 3 * DM, RSV, out + O_YP, false, L + 1 == DEPTH); }
        if (L + 1 < DEPTH) GRID_BAR();
    }
#undef GRID_BAR
}

extern "C" void kernel_launch(void* const* d_in, const int* in_sizes, int n_in, void* d_out, int out_size, void* d_ws, size_t ws_size, hipStream_t stream) {
    static int grid = 0;
    if (grid == 0) {
        if (n_in != 22 || (size_t)out_size != O_END || ws_size < WS_END) { fprintf(stderr, "kernel_launch: shape mismatch: n_in %d out %d (want %zu) ws %zu (need %zu); nothing launched\n", n_in, out_size, (size_t)O_END, ws_size, (size_t)WS_END); grid = -1; return; }
        int dev = 0, cus = 0;
        if (hipGetDevice(&dev) != hipSuccess || hipDeviceGetAttribute(&cus, hipDeviceAttributeMultiprocessorCount, dev) != hipSuccess) { grid = -1; return; }
        if (hipFuncSetAttribute((const void*)mega_fwd, hipFuncAttributeMaxDynamicSharedMemorySize, LDS_BYTES) != hipSuccess) { fprintf(stderr, "kernel_launch: hipFuncSetAttribute failed\n"); grid = -1; return; }
        int per_cu = 0;
        if (hipOccupancyMaxActiveBlocksPerMultiprocessor(&per_cu, (const void*)mega_fwd, NWAVES * 64, LDS_BYTES) != hipSuccess || per_cu < 1) fprintf(stderr, "kernel_launch: occupancy query reports %d blocks per CU\n", per_cu);
        (void)hipGetLastError();
        grid = cus;
    }
    if (grid < 0) return;
    if (hipMemsetAsync((char*)d_ws + WS_CTL, 0, CTL_ZERO_BYTES, stream) != hipSuccess) { fprintf(stderr, "kernel_launch: memset failed\n"); return; }
    Args a{};
    for (int i = 0; i < 22; ++i) a.in[i] = (const float*)d_in[i];
    a.out = (float*)d_out; a.ws = (unsigned char*)d_ws; a.grid = grid; a.pad = 0;
    hipLaunchKernelGGL(mega_fwd, dim3(grid), dim3(NWAVES * 64), LDS_BYTES, stream, a);
    const hipError_t le = hipPeekAtLastError();
    if (le != hipSuccess) fprintf(stderr, "kernel_launch: launch failed: %s\n", hipGetErrorName(le));
}
```

```cpp
#include <hip/hip_runtime.h>
#include <cstdio>
#include <cstdint>

#define LAS __attribute__((address_space(3)))
#define GAS __attribute__((address_space(1)))
typedef unsigned short bf16_t;
typedef short bf16x8 __attribute__((ext_vector_type(8)));
typedef short s16x4 __attribute__((ext_vector_type(4)));
typedef float f32x2 __attribute__((ext_vector_type(2)));
typedef float f32x4 __attribute__((ext_vector_type(4)));
typedef float f32x16 __attribute__((ext_vector_type(16)));
typedef unsigned u32x2 __attribute__((ext_vector_type(2)));
typedef unsigned u32x4 __attribute__((ext_vector_type(4)));

constexpr int DM = 2048, NBP = 4, SEQ = 8192, MP = NBP * SEQ, NBS = 16, SSEQ = 32, MS = NBS * SSEQ, MALL = MP + MS, PAST = 4096, DEPTH = 4;
constexpr int QL = 512, KVL = 512, AROPE = 64, ANOPE = 128, AVD = 128, AH = 16, AQK = 192, AIN = 1088, AINP = 1280, AQB = AH * AQK;
constexpr int BH = 32, BKVH = 8, BHD = 64, BQKV = (BH + 2 * BKVH) * BHD, WIN = 128;
constexpr int DFF = 5632, DFF2 = 2 * DFF;
constexpr int SKEYS = PAST + SSEQ, SKN = 4352, SKK = 4224, QAK = 640, SPITCH = 2 * SKN;
constexpr float EPS = 1e-6f;
constexpr float A_SCALE = 0.07216878364870323f;
constexpr float B_SCALE = 0.125f;
constexpr float LOG2E = 1.4426950408889634f;

constexpr size_t O_YP = 0, O_YS = O_YP + (size_t)MP * DM, O_CKVP = O_YS + (size_t)MS * DM, O_KPEP = O_CKVP + 2ull * MP * KVL, O_WKP = O_KPEP + 2ull * MP * AROPE,
                 O_WVP = O_WKP + 2ull * NBP * WIN * 512, O_FCP = O_WVP + 2ull * NBP * WIN * 512, O_CKVS = O_FCP + 4ull * NBP * 2 * DFF, O_KPES = O_CKVS + 2ull * MS * KVL,
                 O_WKS = O_KPES + 2ull * MS * AROPE, O_WVS = O_WKS + 2ull * NBS * WIN * 512, O_FCS = O_WVS + 2ull * NBS * WIN * 512, O_END = O_FCS + 4ull * NBS * 2 * DFF;

constexpr size_t MiB = 1ull << 20;
constexpr size_t WS_CTL = 0, CTL_ZERO_BYTES = 64 * 1024;
constexpr size_t WS_ROPEA = 1 * MiB, WS_ROPEB = 3 * MiB, WS_RS = 3 * MiB + 512 * 1024;
constexpr size_t WS_W = 4 * MiB;
constexpr size_t W_MLA = WS_W, W_MLA_STRIDE = 22 * MiB;
constexpr size_t W_SWA = WS_W + 44 * MiB, W_SWA_STRIDE = 20 * MiB;
constexpr size_t W_FFN = WS_W + 84 * MiB, W_FFN_STRIDE = 66 * MiB;
constexpr size_t WS_R2 = 352 * MiB;
constexpr size_t WS_R3 = 482 * MiB;
constexpr size_t WS_R4 = 742 * MiB;
constexpr size_t WS_R5 = 1100 * MiB;
constexpr size_t WS_END = 1304 * MiB;
constexpr int CW_BAR = 1024;

__device__ __forceinline__ unsigned f2bf(float f) { unsigned u = __builtin_bit_cast(unsigned, f); return (u + 0x7fffu + ((u >> 16) & 1u)) >> 16; }
__device__ __forceinline__ unsigned cvt_pk_bf16(float lo, float hi) { unsigned r; asm volatile("v_cvt_pk_bf16_f32 %0, %1, %2" : "=v"(r) : "v"(lo), "v"(hi)); return r; }
__device__ __forceinline__ unsigned pk2(float lo, float hi) { return cvt_pk_bf16(lo, hi); }
__device__ __forceinline__ float bf2f(unsigned b) { return __builtin_bit_cast(float, b << 16); }
__device__ __forceinline__ float lane_xor(float v, int lane, int mask) { return __builtin_bit_cast(float, __builtin_amdgcn_ds_bpermute((lane ^ mask) << 2, __builtin_bit_cast(int, v))); }
__device__ __forceinline__ float wave_sum(float v, int lane) {
#pragma unroll
    for (int o = 1; o < 64; o <<= 1) v += lane_xor(v, lane, o);
    return v;
}
__device__ __forceinline__ float wave_max(float v, int lane) {
#pragma unroll
    for (int o = 1; o < 64; o <<= 1) v = fmaxf(v, lane_xor(v, lane, o));
    return v;
}
#define LDS_WAIT() asm volatile("s_waitcnt lgkmcnt(0)" ::: "memory")
#define VM_WAIT() asm volatile("s_waitcnt vmcnt(0)" ::: "memory")
template <int CTRL> __device__ __forceinline__ float dpp_upd(float old, float src) {
    return __builtin_bit_cast(float, __builtin_amdgcn_update_dpp(__builtin_bit_cast(int, old), __builtin_bit_cast(int, src), CTRL, 0xf, 0xf, false));
}
__device__ __forceinline__ int tid_fresh() { int t = threadIdx.x; asm volatile("" : "+v"(t)); return t; }
template <int CTRL> __device__ __forceinline__ float dpp_mov(float src) {
    return __builtin_bit_cast(float, __builtin_amdgcn_mov_dpp(__builtin_bit_cast(int, src), CTRL, 0xf, 0xf, false));
}
__device__ __forceinline__ int bx_fresh() { int b = blockIdx.x; asm volatile("" : "+s"(b)); return b; }
__device__ __forceinline__ int row_pos(int R) { return R < MP ? (R & (SEQ - 1)) : PAST + ((R - MP) & (SSEQ - 1)); }

namespace pg8 {
constexpr int BM = 256, BK = 64, HALF = 128, HTB = HALF * BK * 2, STAGE_BYTES = 8 * HTB, NXCD = 8, WGM = 8;
__host__ __device__ __forceinline__ int lds_byte(int r, int c) { const int st = (r >> 4) * 2 + (c >> 5), rr = r & 15, cc = c & 31, ob = rr * 64 + cc * 2; return st * 1024 + (ob ^ (((ob >> 9) & 1) << 5)); }
__host__ __device__ __forceinline__ void stage_rc(int b, int& R, int& C) { const int st = b / 1024, sb = b % 1024, swz = sb ^ (((sb >> 9) & 1) << 5); R = (st >> 1) * 16 + swz / 64; C = (st & 1) * 32 + (swz % 64) / 2; }
__host__ __device__ __forceinline__ int perm32(int rho) { const int n = rho >> 4, i = rho & 15; return 8 * (i >> 2) + 4 * n + (i & 3); }

struct Unit { int pm, pn, pb, pk; };
struct Gemm { const bf16_t* A; const bf16_t* Bt; int K, lda, ldb; size_t sA, sB; size_t sK = 0; };

struct StaticOrder {
    int nM, nN, nwg, G, c;
    __device__ __forceinline__ void init(int M, int N, int G_, int c_) { nM = M / BM; nN = N / BM; nwg = nM * nN; G = G_; c = c_; }
    __device__ __forceinline__ bool next(int i, Unit& u) const {
        const long L = (long)i * G + c; if (L >= nwg) return false;
        int wgid = (int)L; { const int q = nwg / NXCD, r = nwg % NXCD, xcd = wgid % NXCD, off = wgid / NXCD; wgid = (xcd < r ? xcd * (q + 1) : r * (q + 1) + (xcd - r) * q) + off; }
        const int nig = WGM * nN, gid = wgid / nig, fm = gid * WGM, gsz = (nM - fm) < WGM ? (nM - fm) : WGM;
        u.pm = fm + ((wgid % nig) % gsz); u.pn = (wgid % nig) / gsz; u.pb = 0; u.pk = 0; return true;
    }
};
struct BatchSplitOrder {
    int nM, nN, nB, nK, G, c;
    __device__ __forceinline__ bool next(int i, Unit& u) const {
        const int L = i * G + c; if (L >= nB * nK * nM * nN) return false;
        const int t = nM * nN, q = L / t, r = L - q * t; u.pb = q / nK; u.pk = q - u.pb * nK; u.pn = r / nM; u.pm = r - u.pn * nM; return true;
    }
};
struct BatchOrder {
    int nM, nN, nB, G, c;
    __device__ __forceinline__ bool next(int i, Unit& u) const {
        const int L = i * G + c; if (L >= nB * nM * nN) return false;
        u.pb = L / (nM * nN); const int r = L - u.pb * (nM * nN); u.pn = r / nM; u.pm = r - u.pn * nM; u.pk = 0; return true;
    }
};

template <class Epi, class Sched, bool ALIGN_EPI>
__device__ __forceinline__ void gemm_phase(LAS unsigned char* lds, const Gemm g, const Sched& S, const Epi& E) {
    const int tid = tid_fresh(), wid = __builtin_amdgcn_readfirstlane(tid >> 6), lane = tid & 63, wr = wid >> 2, wc = wid & 3, fr = lane & 15, fq = lane >> 4;
    const int K = g.K, nt = K / BK;
    unsigned voffA[2], voffB[2];
#pragma unroll
    for (int i = 0; i < 2; ++i) { int R, C; stage_rc(tid * 16 + i * 8192, R, C); const int Rb = Epi::PERM ? ((R & ~31) + perm32(R & 31)) : R;
        voffA[i] = (unsigned)(R * g.lda + C) * 2u; voffB[i] = (unsigned)(Rb * g.ldb + C) * 2u; }
    const size_t kstep = (size_t)(BK * 2);
    const size_t hstepA = (size_t)HALF * g.lda * 2, hstepB = (size_t)HALF * g.ldb * 2;
    const size_t tstepA = 2 * hstepA, tstepB = 2 * hstepB;
    const unsigned ldsw = (unsigned)wid * 1024u;
    const int aoff = lds_byte(wr * 64 + fr, fq * 8), boff = lds_byte(wc * 32 + fr, fq * 8);
#define PG8_SA(b, h) (((b) * 2 + (h)) * HTB)
#define PG8_SB(b, h) ((4 + (b) * 2 + (h)) * HTB)
#define PG8_STAGE(bufoff, gbase, voff) do { _Pragma("unroll") for (int _i = 0; _i < 2; ++_i) \
        __builtin_amdgcn_global_load_lds((const unsigned*)((const char*)(gbase) + (voff)[_i]), (LAS unsigned*)(lds + (bufoff) + ldsw + _i * 8192), 16, 0, 0); } while (0)
#define PG8_LDA(dst, b, h) do { _Pragma("unroll") for (int m = 0; m < 4; ++m) _Pragma("unroll") for (int k = 0; k < 2; ++k) dst[m][k] = *(const LAS bf16x8*)(lds + PG8_SA(b, h) + aoff + m * 2048 + k * 1024); } while (0)
#define PG8_LDB(dst, b, h) do { _Pragma("unroll") for (int n = 0; n < 2; ++n) _Pragma("unroll") for (int k = 0; k < 2; ++k) dst[n][k] = *(const LAS bf16x8*)(lds + PG8_SB(b, h) + boff + n * 2048 + k * 1024); } while (0)
#define PG8_MMA(ai, bj, At, Bt) do { __builtin_amdgcn_s_setprio(1); _Pragma("unroll") for (int m = 0; m < 4; ++m) _Pragma("unroll") for (int n = 0; n < 2; ++n) _Pragma("unroll") for (int k = 0; k < 2; ++k) \
        acc[ai][bj][m][n] = __builtin_amdgcn_mfma_f32_16x16x32_bf16(Bt[n][k], At[m][k], acc[ai][bj][m][n], 0, 0, 0); __builtin_amdgcn_s_setprio(0); } while (0)
#define PG8_WAIT_V(n) asm volatile("s_waitcnt vmcnt(" #n ")" ::: "memory")
#define PG8_WAIT_L(n) asm volatile("s_waitcnt lgkmcnt(" #n ")" ::: "memory")
#define PG8_BAR __builtin_amdgcn_s_barrier()
#define PG8_SCHED __builtin_amdgcn_sched_barrier(0)
    Unit cur, nxt; int ui = 0;
    if (!S.next(0, cur)) return;
    f32x4 acc[2][2][4][2];
#pragma unroll
    for (int a = 0; a < 2; ++a)
#pragma unroll
        for (int b = 0; b < 2; ++b)
#pragma unroll
            for (int m = 0; m < 4; ++m)
#pragma unroll
                for (int n = 0; n < 2; ++n) acc[a][b][m][n] = (f32x4){0.f, 0.f, 0.f, 0.f};
    bf16x8 At[4][2], B0[2][2], B1[2][2];
    const char* cA = (const char*)g.A + ((size_t)cur.pb * g.sA + (size_t)cur.pk * g.sK) * 2 + (size_t)cur.pm * tstepA;
    const char* cB = (const char*)g.Bt + ((size_t)cur.pb * g.sB + (size_t)cur.pk * g.sK) * 2 + (size_t)cur.pn * tstepB;
    PG8_STAGE(PG8_SB(0, 0), cB, voffB); PG8_STAGE(PG8_SB(0, 1), cB + hstepB, voffB); PG8_STAGE(PG8_SA(0, 0), cA, voffA); PG8_STAGE(PG8_SA(0, 1), cA + hstepA, voffA);
    if (wr == 1) PG8_BAR;
    PG8_WAIT_V(2); PG8_BAR;
    PG8_STAGE(PG8_SB(1, 0), cB + kstep, voffB); PG8_STAGE(PG8_SA(1, 0), cA + kstep, voffA); PG8_STAGE(PG8_SB(1, 1), cB + hstepB + kstep, voffB);
    PG8_WAIT_V(6); PG8_BAR;
    for (;;) {
        const bool has_next = S.next(ui + 1, nxt);
        const char* nA = has_next ? (const char*)g.A + ((size_t)nxt.pb * g.sA + (size_t)nxt.pk * g.sK) * 2 + (size_t)nxt.pm * tstepA : cA;
        const char* nB = has_next ? (const char*)g.Bt + ((size_t)nxt.pb * g.sB + (size_t)nxt.pk * g.sK) * 2 + (size_t)nxt.pn * tstepB : cB;
        for (int t = 0; t < nt; t += 2) {
            const bool last = (t == nt - 2);
            const char* a1 = cA + (size_t)(t + 1) * kstep;
            const char* a2 = last ? nA : cA + (size_t)(t + 2) * kstep; const char* b2 = last ? nB : cB + (size_t)(t + 2) * kstep;
            const char* a3 = a2 + kstep; const char* b3 = b2 + kstep;
            PG8_LDB(B0, 0, 0); PG8_LDB(B1, 0, 1); PG8_SCHED; PG8_LDA(At, 0, 0); PG8_STAGE(PG8_SA(1, 1), a1 + hstepA, voffA);
            PG8_WAIT_V(8); PG8_WAIT_L(0); PG8_BAR; PG8_MMA(0, 0, At, B0); PG8_MMA(0, 1, At, B1); PG8_BAR; PG8_SCHED;
            PG8_LDA(At, 0, 1); PG8_STAGE(PG8_SB(0, 0), b2, voffB); PG8_STAGE(PG8_SB(0, 1), b2 + hstepB, voffB); PG8_STAGE(PG8_SA(0, 0), a2, voffA);
            PG8_WAIT_V(8); PG8_WAIT_L(0); PG8_BAR; PG8_MMA(1, 0, At, B0); PG8_MMA(1, 1, At, B1); PG8_BAR; PG8_SCHED;
            PG8_LDB(B0, 1, 0); PG8_LDB(B1, 1, 1); PG8_SCHED; PG8_LDA(At, 1, 0); PG8_STAGE(PG8_SA(0, 1), a2 + hstepA, voffA);
            PG8_WAIT_V(8); PG8_WAIT_L(0); PG8_BAR; PG8_MMA(0, 0, At, B0); PG8_MMA(0, 1, At, B1); PG8_BAR; PG8_SCHED;
            PG8_LDA(At, 1, 1); PG8_STAGE(PG8_SB(1, 0), b3, voffB); PG8_STAGE(PG8_SB(1, 1), b3 + hstepB, voffB); PG8_STAGE(PG8_SA(1, 0), a3, voffA);
            PG8_WAIT_V(8); PG8_WAIT_L(0); PG8_BAR; PG8_MMA(1, 0, At, B0); PG8_MMA(1, 1, At, B1); PG8_BAR; PG8_SCHED;
        }
        if constexpr (ALIGN_EPI) { if (wr == 0) PG8_BAR; }
        E(acc, cur, wr, wc, fr, fq);
        if (!has_next) break;
#pragma unroll
        for (int a = 0; a < 2; ++a)
#pragma unroll
            for (int b = 0; b < 2; ++b)
#pragma unroll
                for (int m = 0; m < 4; ++m)
#pragma unroll
                    for (int n = 0; n < 2; ++n) acc[a][b][m][n] = (f32x4){0.f, 0.f, 0.f, 0.f};
        cur = nxt; cA = nA; cB = nB; ++ui;
        if constexpr (ALIGN_EPI) { if (wr == 1) PG8_BAR; }
    }
    PG8_WAIT_V(0);
    if constexpr (!ALIGN_EPI) { if (wr == 0) PG8_BAR; }
    PG8_BAR;
#undef PG8_SA
#undef PG8_SB
#undef PG8_STAGE
#undef PG8_LDA
#undef PG8_LDB
#undef PG8_MMA
#undef PG8_WAIT_V
#undef PG8_WAIT_L
#undef PG8_BAR
#undef PG8_SCHED
}

template <bool SCALE> struct EpiF32 {
    static constexpr bool PERM = false;
    float* C; int ldc; size_t sC; const float* rs; size_t sCk = 0;
    __device__ __forceinline__ void operator()(const f32x4 (&acc)[2][2][4][2], const Unit& u, int wr, int wc, int fr, int fq) const {
        const int row0 = u.pm * BM + wr * 64 + fr, col0 = u.pn * BM + wc * 32 + 4 * fq;
        float* base = C + (size_t)u.pb * sC + (size_t)u.pk * sCk;
#pragma unroll
        for (int ai = 0; ai < 2; ++ai)
#pragma unroll
            for (int m = 0; m < 4; ++m) { float* rowp = base + (size_t)(row0 + ai * HALF + m * 16) * ldc + col0; const float sc = SCALE ? rs[row0 + ai * HALF + m * 16] : 1.f;
#pragma unroll
                for (int bj = 0; bj < 2; ++bj)
#pragma unroll
                    for (int n = 0; n < 2; ++n) *(f32x4*)(rowp + bj * HALF + n * 16) = acc[ai][bj][m][n] * sc; }
    }
};
struct EpiBf16 {
    static constexpr bool PERM = true;
    bf16_t* O; int ldc; int split_cols; ptrdiff_t split_stride; size_t sC;
    __device__ __forceinline__ void operator()(const f32x4 (&acc)[2][2][4][2], const Unit& u, int wr, int wc, int fr, int fq) const {
        const int row0 = u.pm * BM + wr * 64 + fr; int colt = u.pn * BM; bf16_t* base = O + (size_t)u.pb * sC;
        if (split_cols) { const int t = colt / split_cols; base += (ptrdiff_t)t * split_stride; colt -= t * split_cols; }
        const int col0 = colt + wc * 32 + 8 * fq;
#pragma unroll
        for (int ai = 0; ai < 2; ++ai)
#pragma unroll
            for (int m = 0; m < 4; ++m) { bf16_t* rowp = base + (size_t)(row0 + ai * HALF + m * 16) * ldc + col0;
#pragma unroll
                for (int bj = 0; bj < 2; ++bj) { const f32x4 v0 = acc[ai][bj][m][0], v1 = acc[ai][bj][m][1];
                    u32x4 w; w.x = cvt_pk_bf16(v0[0], v0[1]); w.y = cvt_pk_bf16(v0[2], v0[3]); w.z = cvt_pk_bf16(v1[0], v1[1]); w.w = cvt_pk_bf16(v1[2], v1[3]);
                    *(u32x4*)(rowp + bj * HALF) = w; } }
    }
};
__device__ __forceinline__ void rope8(f32x4& v0, f32x4& v1, const f32x4 c01, const f32x4 c23) {
    f32x4 a = v0, b = v1;
    v0[0] = a[0] * c01[0] - a[1] * c01[1]; v0[1] = a[0] * c01[1] + a[1] * c01[0];
    v0[2] = a[2] * c01[2] - a[3] * c01[3]; v0[3] = a[2] * c01[3] + a[3] * c01[2];
    v1[0] = b[0] * c23[0] - b[1] * c23[1]; v1[1] = b[0] * c23[1] + b[1] * c23[0];
    v1[2] = b[2] * c23[2] - b[3] * c23[3]; v1[3] = b[2] * c23[3] + b[3] * c23[2];
}
struct EpiQMla {
    static constexpr bool PERM = true;
    bf16_t* Q; const float* ropeA;
    __device__ __forceinline__ void operator()(const f32x4 (&acc)[2][2][4][2], const Unit& u, int wr, int wc, int fr, int fq) const {
        const int row0 = u.pm * BM + wr * 64 + fr, col0 = u.pn * BM + wc * 32 + 8 * fq;
#pragma unroll
        for (int ai = 0; ai < 2; ++ai)
#pragma unroll
            for (int m = 0; m < 4; ++m) { const int R = row0 + ai * HALF + m * 16; const int pos = row_pos(R); bf16_t* rowp = Q + (size_t)R * AQB + col0;
#pragma unroll
                for (int bj = 0; bj < 2; ++bj) { f32x4 v0 = acc[ai][bj][m][0], v1 = acc[ai][bj][m][1];
                    const int col = col0 + bj * HALF, w = col % AQK;
                    if (w >= ANOPE) { const float* cs = ropeA + ((size_t)pos * 32 + ((w - ANOPE) >> 1)) * 2; rope8(v0, v1, *(const f32x4*)cs, *(const f32x4*)(cs + 4)); }
                    u32x4 o; o.x = cvt_pk_bf16(v0[0], v0[1]); o.y = cvt_pk_bf16(v0[2], v0[3]); o.z = cvt_pk_bf16(v1[0], v1[1]); o.w = cvt_pk_bf16(v1[2], v1[3]);
                    *(u32x4*)(rowp + bj * HALF) = o; } }
    }
};
struct EpiQkvSwa {
    static constexpr bool PERM = true;
    bf16_t *Q, *Kb, *Vb, *ksamp, *vsamp; const float* ropeB; float *wkp, *wvp, *wks, *wvs; const float* rs;
    __device__ __forceinline__ void operator()(const f32x4 (&acc)[2][2][4][2], const Unit& u, int wr, int wc, int fr, int fq) const {
        const int row0 = u.pm * BM + wr * 64 + fr, colt = u.pn * BM, col0 = colt + wc * 32 + 8 * fq;
        const int kind = colt < 2048 ? 0 : (colt < 2560 ? 1 : 2);
#pragma unroll
        for (int ai = 0; ai < 2; ++ai)
#pragma unroll
            for (int m = 0; m < 4; ++m) { const int R = row0 + ai * HALF + m * 16; const int pos = row_pos(R); const float sc = rs[R];
#pragma unroll
                for (int bj = 0; bj < 2; ++bj) { f32x4 v0 = acc[ai][bj][m][0] * sc, v1 = acc[ai][bj][m][1] * sc;
                    const int col = col0 + bj * HALF, w = col & 63;
                    const bool rot = (kind != 2) && (w < 16);
                    if (rot) { const float* cs = ropeB + ((size_t)pos * 8 + (w >> 1)) * 2; rope8(v0, v1, *(const f32x4*)cs, *(const f32x4*)(cs + 4)); }
                    u32x4 o; o.x = cvt_pk_bf16(v0[0], v0[1]); o.y = cvt_pk_bf16(v0[2], v0[3]); o.z = cvt_pk_bf16(v1[0], v1[1]); o.w = cvt_pk_bf16(v1[2], v1[3]);
                    if (kind == 0) { *(u32x4*)(Q + (size_t)R * 2048 + col) = o; }
                    else {
                        const int c = col - (kind == 1 ? 2048 : 2560);
                        bf16_t* dst = (kind == 1 ? Kb : Vb) + (size_t)R * 512 + c; *(u32x4*)dst = o;
                        float* outp = nullptr;
                        if (R < MP) { const int t = R & (SEQ - 1); if (t >= SEQ - WIN) outp = (kind == 1 ? wkp : wvp) + ((size_t)(R >> 13) * WIN + (t - (SEQ - WIN))) * 512 + (c - w); }
                        else { const int rs = R - MP, b = rs >> 5, t = rs & 31; outp = (kind == 1 ? wks : wvs) + ((size_t)b * WIN + 96 + t) * 512 + (c - w);
                               bf16_t* sd = (kind == 1 ? ksamp : vsamp) + ((size_t)b * 192 + 128 + t) * 512 + c; *(u32x4*)sd = o; }
                        if (outp) {
                            if (rot) {
#pragma unroll
                                for (int e = 0; e < 8; ++e) { const int vv = w + e; outp[(vv & 1) * 8 + (vv >> 1)] = e < 4 ? v0[e & 3] : v1[e & 3]; }
                            } else { *(f32x4*)(outp + w) = v0; *(f32x4*)(outp + w + 4) = v1; }
                        }
                    } } }
    }
};
struct EpiFfnS {
    static constexpr bool PERM = true;
    float *Gs, *Us; const float* rs;
    __device__ __forceinline__ void operator()(const f32x4 (&acc)[2][2][4][2], const Unit& u, int wr, int wc, int fr, int fq) const {
        const int ch0 = u.pn * HALF + wc * 32 + 8 * fq, r0 = u.pm * BM + wr * 64 + fr;
        float* gs = Gs + (size_t)u.pb * MS * DFF; float* us = Us + (size_t)u.pb * MS * DFF;
#pragma unroll
        for (int ai = 0; ai < 2; ++ai)
#pragma unroll
            for (int m = 0; m < 4; ++m) { const size_t off = (size_t)(r0 + ai * HALF + m * 16) * DFF + ch0; const float sc = rs[MP + r0 + ai * HALF + m * 16];
                *(f32x4*)(gs + off) = acc[ai][0][m][0] * sc; *(f32x4*)(gs + off + 4) = acc[ai][0][m][1] * sc; *(f32x4*)(us + off) = acc[ai][1][m][0] * sc; *(f32x4*)(us + off + 4) = acc[ai][1][m][1] * sc; }
    }
};
struct EpiFfn {
    static constexpr bool PERM = true;
    bf16_t* act; const float* cw; const float* cb; float *Gh, *Uh; const float* rs;
    __device__ __forceinline__ void operator()(const f32x4 (&acc)[2][2][4][2], const Unit& u, int wr, int wc, int fr, int fq) const {
        const int ch0 = u.pn * HALF + wc * 32 + 8 * fq;
        float w0[8], w1[8], w2[8], bb[8];
#pragma unroll
        for (int e = 0; e < 8; ++e) { w0[e] = cw[ch0 + e] * LOG2E; w1[e] = cw[DFF + ch0 + e] * LOG2E; w2[e] = cw[2 * DFF + ch0 + e] * LOG2E; bb[e] = cb[ch0 + e] * LOG2E; }
#pragma unroll
        for (int ai = 0; ai < 2; ++ai) {
            const int blk = u.pm * 4 + ai * 2 + wr;
            float prev[8];
#pragma unroll
            for (int e = 0; e < 8; ++e) prev[e] = 0.f;
#pragma unroll
            for (int m = 0; m < 4; ++m) {
                const int R = u.pm * BM + ai * HALF + wr * 64 + m * 16 + fr;
                float g[8], up[8], a[8]; const float sc = rs[R], scu = sc * 0.6931471805599453f;
#pragma unroll
                for (int e = 0; e < 4; ++e) { g[e] = acc[ai][0][m][0][e] * sc; g[4 + e] = acc[ai][0][m][1][e] * sc; up[e] = acc[ai][1][m][0][e] * scu; up[4 + e] = acc[ai][1][m][1][e] * scu; }
#pragma unroll
                for (int e = 0; e < 8; ++e) {
                    const float p1 = dpp_mov<0x121>(prev[e]), s1 = dpp_upd<0x111>(p1, g[e]);
                    const float p2 = dpp_mov<0x122>(prev[e]), s2 = dpp_upd<0x112>(p2, g[e]);
                    const float cvl = fmaf(w0[e], s2, fmaf(w1[e], s1, fmaf(w2[e], g[e], bb[e])));
                    a[e] = cvl * up[e] * __builtin_amdgcn_rcpf(1.f + __builtin_amdgcn_exp2f(-cvl));
                    prev[e] = g[e];
                }
                if (!(m == 0 && fr < 2)) {
                    u32x4 o; o.x = cvt_pk_bf16(a[0], a[1]); o.y = cvt_pk_bf16(a[2], a[3]); o.z = cvt_pk_bf16(a[4], a[5]); o.w = cvt_pk_bf16(a[6], a[7]);
                    *(u32x4*)(act + (size_t)R * DFF + ch0) = o;
                }
                if (m == 0 && fr < 2) {
                    float* gp = Gh + ((size_t)blk * 4 + 2 + fr) * DFF + ch0; float* upp = Uh + ((size_t)blk * 2 + fr) * DFF + ch0;
                    *(f32x4*)gp = (f32x4){g[0], g[1], g[2], g[3]}; *(f32x4*)(gp + 4) = (f32x4){g[4], g[5], g[6], g[7]};
                    *(f32x4*)upp = (f32x4){up[0], up[1], up[2], up[3]} * LOG2E; *(f32x4*)(upp + 4) = (f32x4){up[4], up[5], up[6], up[7]} * LOG2E;
                }
                if (m == 3 && fr >= 14) {
                    float* gp = Gh + ((size_t)blk * 4 + (fr - 14)) * DFF + ch0;
                    *(f32x4*)gp = (f32x4){g[0], g[1], g[2], g[3]}; *(f32x4*)(gp + 4) = (f32x4){g[4], g[5], g[6], g[7]};
                }
            }
        }
    }
};
}

namespace att {
#define SBAR() __builtin_amdgcn_sched_barrier(0)
__device__ __forceinline__ int crow(int r, int hi) { return (r & 3) + 8 * (r >> 2) + 4 * hi; }
template <int ROWB> __device__ __forceinline__ int kswz(int row, int colB) { return row * ROWB + (colB ^ (((row >> 1) & 7) << 4)); }
template <int NCB> __device__ __forceinline__ int v_st(int k, int c) { const int kk = (k & ~0xC) | ((k & 4) << 1) | ((k & 8) >> 1); return ((kk >> 3) * NCB + (c >> 5)) * 512 + ((kk & 7) * 32 + (c & 31)) * 2; }
__device__ __forceinline__ int v_rd_base(int lane) { return ((lane & 3) << 3) | (((lane >> 2) & 3) << 6) | (((lane >> 4) & 1) << 5) | (((lane >> 5) & 1) << 8); }
template <int OFF> __device__ __forceinline__ s16x4 tr_read(int vb) { s16x4 r; asm volatile("ds_read_b64_tr_b16 %0, %1 offset:%2" : "=&v"(r) : "v"(vb), "i"(OFF) : "memory"); return r; }

__device__ __forceinline__ void partialSM(f32x16& p0, f32x16& p1, float& m_reg, float& alpha, const float C, const float thr_raw) {
    float pmax = p0[0];
#pragma unroll
    for (int r = 1; r < 16; ++r) pmax = fmaxf(pmax, p0[r]);
#pragma unroll
    for (int r = 0; r < 16; ++r) pmax = fmaxf(pmax, p1[r]);
    { auto rr = __builtin_amdgcn_permlane32_swap(__float_as_uint(pmax), __float_as_uint(pmax), false, false); pmax = fmaxf(__uint_as_float(rr[0]), __uint_as_float(rr[1])); }
    float mn;
    if (__all(pmax - m_reg <= thr_raw)) { mn = m_reg; alpha = 1.f; }
    else { mn = fmaxf(m_reg, pmax); alpha = __builtin_amdgcn_exp2f((m_reg - mn) * C); m_reg = mn; }
    const float mnC = -mn * C;
#pragma unroll
    for (int r = 0; r < 16; ++r) p0[r] = __builtin_amdgcn_exp2f(fmaf(p0[r], C, mnC));
#pragma unroll
    for (int r = 0; r < 16; ++r) p1[r] = __builtin_amdgcn_exp2f(fmaf(p1[r], C, mnC));
}
__device__ __forceinline__ void finishSM(const f32x16& p0, const f32x16& p1, float alpha, float& l_reg, bf16x8& pa0, bf16x8& pa1, bf16x8& pa2, bf16x8& pa3) {
    float ps = 0.f;
#pragma unroll
    for (int r = 0; r < 16; ++r) ps += p0[r];
#pragma unroll
    for (int r = 0; r < 16; ++r) ps += p1[r];
    { auto rr = __builtin_amdgcn_permlane32_swap(__float_as_uint(ps), __float_as_uint(ps), false, false); ps = __uint_as_float(rr[0]) + __uint_as_float(rr[1]); }
    l_reg = l_reg * alpha + ps;
#define PK4(P, BASE, OUT) do { unsigned a0 = cvt_pk_bf16(P[BASE + 0], P[BASE + 1]), a1 = cvt_pk_bf16(P[BASE + 2], P[BASE + 3]);   \
    unsigned b0 = cvt_pk_bf16(P[BASE + 4], P[BASE + 5]), b1 = cvt_pk_bf16(P[BASE + 6], P[BASE + 7]);                              \
    auto r0 = __builtin_amdgcn_permlane32_swap(a0, b0, false, false); auto r1 = __builtin_amdgcn_permlane32_swap(a1, b1, false, false); \
    u32x4 w = {r0[0], r1[0], r0[1], r1[1]}; OUT = __builtin_bit_cast(bf16x8, w); } while (0)
    PK4(p0, 0, pa0); PK4(p0, 8, pa1); PK4(p1, 0, pa2); PK4(p1, 8, pa3);
#undef PK4
}
template <int DQK> __device__ __forceinline__ void qkt(f32x16& p0, f32x16& p1, const LAS unsigned char* Ks, const bf16x8* qr, int r32, int hi) {
    p0 = f32x16{}; p1 = f32x16{};
#pragma unroll
    for (int d0 = 0; d0 < DQK / 16; ++d0) { const int cb = (d0 * 16 + hi * 8) * 2;
        const bf16x8 b0 = *(const LAS bf16x8*)(Ks + kswz<DQK * 2>(r32, cb));
        const bf16x8 b1 = *(const LAS bf16x8*)(Ks + kswz<DQK * 2>(32 + r32, cb));
        p0 = __builtin_amdgcn_mfma_f32_32x32x16_bf16(b0, qr[d0], p0, 0, 0, 0);
        p1 = __builtin_amdgcn_mfma_f32_32x32x16_bf16(b1, qr[d0], p1, 0, 0, 0); }
}
template <int NCB, int D0> __device__ __forceinline__ void pv_one(f32x16& od, int vb, bf16x8 pa0, bf16x8 pa1, bf16x8 pa2, bf16x8 pa3) {
    constexpr int KS = 2 * NCB * 512, HF = NCB * 512;
    const s16x4 l0 = tr_read<D0 * 512 + 0 * KS>(vb), h0 = tr_read<D0 * 512 + 0 * KS + HF>(vb), l1 = tr_read<D0 * 512 + 1 * KS>(vb), h1 = tr_read<D0 * 512 + 1 * KS + HF>(vb);
    const s16x4 l2 = tr_read<D0 * 512 + 2 * KS>(vb), h2 = tr_read<D0 * 512 + 2 * KS + HF>(vb), l3 = tr_read<D0 * 512 + 3 * KS>(vb), h3 = tr_read<D0 * 512 + 3 * KS + HF>(vb);
    asm volatile("s_waitcnt lgkmcnt(0)" ::: "memory"); SBAR();
#define PK(L, H) (bf16x8){L[0], L[1], L[2], L[3], H[0], H[1], H[2], H[3]}
    od = __builtin_amdgcn_mfma_f32_32x32x16_bf16(pa0, PK(l0, h0), od, 0, 0, 0);
    od = __builtin_amdgcn_mfma_f32_32x32x16_bf16(pa1, PK(l1, h1), od, 0, 0, 0);
    od = __builtin_amdgcn_mfma_f32_32x32x16_bf16(pa2, PK(l2, h2), od, 0, 0, 0);
    od = __builtin_amdgcn_mfma_f32_32x32x16_bf16(pa3, PK(l3, h3), od, 0, 0, 0);
#undef PK
}
#define ATT_RESC(NO, a) do { if (__any((a) < 1.f)) { if (hi == 0) al_l[r32] = (a); asm volatile("s_waitcnt lgkmcnt(0)" ::: "memory"); \
    _Pragma("unroll") for (int d = 0; d < NO; ++d) _Pragma("unroll") for (int r = 0; r < 16; ++r) o[d][r] *= al_l[crow(r, hi)]; } } while (0)

constexpr int MLA_KB = 64 * 192 * 2, MLA_VB = 64 * 128 * 2;
constexpr int MLA_LDS = 2 * MLA_KB + 2 * MLA_VB + 8 * 256;
__device__ __forceinline__ void mla_unit(LAS unsigned char* lds, int b, int h, int qb, const bf16_t* __restrict__ Q, const bf16_t* __restrict__ KN, const bf16_t* __restrict__ KPE,
                                         const bf16_t* __restrict__ V, bf16_t* __restrict__ O) {
    const int tid = tid_fresh(), lane = tid & 63, r32 = lane & 31, hi = lane >> 5; const int wid = __builtin_amdgcn_readfirstlane(tid >> 6);
    LAS unsigned char* Kl = lds; LAS unsigned char* Vl = lds + 2 * MLA_KB; LAS float* al_l = (LAS float*)(lds + 2 * MLA_KB + 2 * MLA_VB) + wid * 64;
    const size_t rowbase = (size_t)b * SEQ; const int q0 = qb * 256;
    const bf16_t* Qw = Q + (rowbase + q0 + wid * 32 + r32) * AQB + h * AQK + hi * 8;
    bf16x8 qr[12];
#pragma unroll
    for (int d0 = 0; d0 < 12; ++d0) qr[d0] = *(const bf16x8*)(Qw + d0 * 16);
    const bf16_t* kn = KN + rowbase * 2048 + h * 128; const bf16_t* kp = KPE + rowbase * 64; const bf16_t* vh = V + rowbase * 2048 + h * 128;
    const bf16_t* kps[3]; unsigned kinc[3]; const bf16_t* vps[2];
#pragma unroll
    for (int i = 0; i < 3; ++i) { const int off = 1024 * (wid + 8 * i) + 16 * lane, row = off / 384, cp = off - row * 384, colB = cp ^ (((row >> 1) & 7) << 4), ch = colB >> 4;
        if (ch < 16) { kps[i] = kn + (size_t)row * 2048 + ch * 8; kinc[i] = 64u * 2048u; } else { kps[i] = kp + (size_t)row * 64 + (ch - 16) * 8; kinc[i] = 64u * 64u; } }
#pragma unroll
    for (int i = 0; i < 2; ++i) { const int off = 1024 * (wid + 8 * i) + 16 * lane, sub = off >> 9, within = (off & 511) >> 1, kk = (sub >> 2) * 8 + (within >> 5);
        const int k = (kk & ~0xC) | ((kk & 4) << 1) | ((kk & 8) >> 1), c = (sub & 3) * 32 + (within & 31); vps[i] = vh + (size_t)k * 2048 + c; }
    const int NT = 4 * qb + 4, tvis = 4 * qb + (wid >> 1);
    const int vb0 = (int)(unsigned)(size_t)Vl + v_rd_base(lane);
    constexpr float C = A_SCALE * LOG2E, THRR = 8.f / A_SCALE;
    float m_reg = -1e30f, l_reg = 0.f; f32x16 o[4]; o[0] = f32x16{}; o[1] = f32x16{}; o[2] = f32x16{}; o[3] = f32x16{};
#define MLA_DMA(t, buf) do { _Pragma("unroll") for (int i = 0; i < 3; ++i) __builtin_amdgcn_global_load_lds((const unsigned*)(kps[i] + (size_t)(t) * kinc[i]), (LAS unsigned*)(Kl + (buf) * MLA_KB + 1024 * (wid + 8 * i)), 16, 0, 0); \
    _Pragma("unroll") for (int i = 0; i < 2; ++i) __builtin_amdgcn_global_load_lds((const unsigned*)(vps[i] + (size_t)(t) * (64 * 2048)), (LAS unsigned*)(Vl + (buf) * MLA_VB + 1024 * (wid + 8 * i)), 16, 0, 0); } while (0)
#define MLA_SYNC() do { asm volatile("s_waitcnt vmcnt(0) lgkmcnt(0)" ::: "memory"); __builtin_amdgcn_s_barrier(); asm volatile("" ::: "memory"); } while (0)
    MLA_SYNC();
    MLA_DMA(0, 0); MLA_SYNC();
    for (int t = 0; t < NT; ++t) {
        const int buf = t & 1;
        if (t + 1 < NT) MLA_DMA(t + 1, buf ^ 1);
        if (t <= tvis) {
            f32x16 p0, p1; float alpha; bf16x8 pa0, pa1, pa2, pa3;
            qkt<192>(p0, p1, Kl + buf * MLA_KB, qr, r32, hi);
            partialSM(p0, p1, m_reg, alpha, C, THRR);
            ATT_RESC(4, alpha);
            finishSM(p0, p1, alpha, l_reg, pa0, pa1, pa2, pa3);
            const int vb = vb0 + buf * MLA_VB;
            pv_one<4, 0>(o[0], vb, pa0, pa1, pa2, pa3); pv_one<4, 1>(o[1], vb, pa0, pa1, pa2, pa3); pv_one<4, 2>(o[2], vb, pa0, pa1, pa2, pa3); pv_one<4, 3>(o[3], vb, pa0, pa1, pa2, pa3);
        }
        MLA_SYNC();
    }
#undef MLA_DMA
#undef MLA_SYNC
    if (hi == 0) al_l[r32] = l_reg; asm volatile("s_waitcnt lgkmcnt(0)" ::: "memory");
    bf16_t* Ow = O + (rowbase + q0 + wid * 32) * 2048 + h * 128;
#pragma unroll
    for (int r = 0; r < 16; ++r) { const int orow = crow(r, hi); const float rl = __builtin_amdgcn_rcpf(al_l[orow]);
#pragma unroll
        for (int d0 = 0; d0 < 4; ++d0) Ow[(size_t)orow * 2048 + d0 * 32 + r32] = (bf16_t)f2bf(o[d0][r] * rl); }
}

constexpr int SWA_KB = 64 * 64 * 2, SWA_VB = 64 * 64 * 2;
constexpr int SWA_LDS = 2 * SWA_KB + 2 * SWA_VB + 8 * 256;
__device__ __forceinline__ void swa_unit(LAS unsigned char* lds, const bf16_t* __restrict__ Qb  , const bf16_t* __restrict__ Kb, const bf16_t* __restrict__ Vb  ,
                                         bf16_t* __restrict__ Ob, int NT, bool last_half, int nwaves_q, int wsh, const float* __restrict__ sinks4) {
    const int tid = tid_fresh(), lane = tid & 63, r32 = lane & 31, hi = lane >> 5; const int wid = __builtin_amdgcn_readfirstlane(tid >> 6);
    LAS unsigned char* Kl = lds; LAS unsigned char* Vl = lds + 2 * SWA_KB; LAS float* al_l = (LAS float*)(lds + 2 * SWA_KB + 2 * SWA_VB) + wid * 64;
    const bool qwave = wid < nwaves_q;
    const int g = wid >> wsh, rloc = 32 * (wid & ((1 << wsh) - 1)) + r32;
    bf16x8 qr[4];
    if (qwave) {
#pragma unroll
        for (int d0 = 0; d0 < 4; ++d0) qr[d0] = *(const bf16x8*)(Qb + (size_t)rloc * 2048 + g * 64 + d0 * 16 + hi * 8);
    } else {
#pragma unroll
        for (int d0 = 0; d0 < 4; ++d0) qr[d0] = bf16x8{};
    }
    const int srow = tid >> 3, sch = tid & 7;
    const bf16_t* ksrc = Kb + (size_t)srow * 512 + sch * 8; const bf16_t* vsrc = Vb + (size_t)srow * 512 + sch * 8;
    const int kdst = kswz<128>(srow, sch * 16), vdst = v_st<2>(srow, sch * 8);
    const int vb0 = (int)(unsigned)(size_t)Vl + v_rd_base(lane);
    constexpr float C = B_SCALE * LOG2E, THRR = 8.f / B_SCALE;
    float m_reg = -1e30f, l_reg = 0.f; f32x16 o[2]; o[0] = f32x16{}; o[1] = f32x16{};
    bf16x8 sk, sv;
    __syncthreads();
    sk = *(const bf16x8*)ksrc; sv = *(const bf16x8*)vsrc;
    *(LAS bf16x8*)(Kl + kdst) = sk; *(LAS bf16x8*)(Vl + vdst) = sv; __syncthreads();
    for (int t = 0; t < NT; ++t) {
        const int buf = t & 1;
        if (t + 1 < NT) { sk = *(const bf16x8*)(ksrc + (size_t)(t + 1) * 64 * 512); sv = *(const bf16x8*)(vsrc + (size_t)(t + 1) * 64 * 512); }
        if (qwave) {
            f32x16 p0, p1; float alpha; bf16x8 pa0, pa1, pa2, pa3;
            qkt<64>(p0, p1, Kl + buf * SWA_KB, qr, r32, hi);
            if (last_half && t == NT - 1) {
#pragma unroll
                for (int r = 0; r < 16; ++r) p1[r] = -1e30f;
            }
            partialSM(p0, p1, m_reg, alpha, C, THRR);
            ATT_RESC(2, alpha);
            finishSM(p0, p1, alpha, l_reg, pa0, pa1, pa2, pa3);
            const int vb = vb0 + buf * SWA_VB;
            pv_one<2, 0>(o[0], vb, pa0, pa1, pa2, pa3); pv_one<2, 1>(o[1], vb, pa0, pa1, pa2, pa3);
        }
        if (t + 1 < NT) { *(LAS bf16x8*)(Kl + (buf ^ 1) * SWA_KB + kdst) = sk; *(LAS bf16x8*)(Vl + (buf ^ 1) * SWA_VB + vdst) = sv; }
        __syncthreads();
    }
    if (qwave) {
        const float sk_l = sinks4[g];
        l_reg += __builtin_amdgcn_exp2f((sk_l - m_reg * B_SCALE) * LOG2E);
        if (hi == 0) al_l[r32] = l_reg; asm volatile("s_waitcnt lgkmcnt(0)" ::: "memory");
        const int rbase = 32 * (wid & ((1 << wsh) - 1));
#pragma unroll
        for (int r = 0; r < 16; ++r) { const int orow = crow(r, hi); const float rl = __builtin_amdgcn_rcpf(al_l[orow]);
#pragma unroll
            for (int d0 = 0; d0 < 2; ++d0) Ob[(size_t)(rbase + orow) * 2048 + g * 64 + d0 * 32 + r32] = (bf16_t)f2bf(o[d0][r] * rl); }
    }
}
__device__ __forceinline__ f32x16 wave_gemm_tile(const bf16_t* __restrict__ A, int lda, const bf16_t* __restrict__ Bt, int ldb, int K, int r32, int hi) {
    f32x16 acc = f32x16{};
    const bf16_t* ap = A + (size_t)r32 * lda + hi * 8; const bf16_t* bp = Bt + (size_t)r32 * ldb + hi * 8;
    for (int k0 = 0; k0 < K; k0 += 128) {
        bf16x8 a[8], b[8];
#pragma unroll
        for (int i = 0; i < 8; ++i) { a[i] = *(const bf16x8*)(ap + k0 + 16 * i); b[i] = *(const bf16x8*)(bp + k0 + 16 * i); }
#pragma unroll
        for (int i = 0; i < 8; ++i) acc = __builtin_amdgcn_mfma_f32_32x32x16_bf16(a[i], b[i], acc, 0, 0, 0);
    }
    return acc;
}
#undef SBAR
}

struct Args { const float* in[22]; float* out; unsigned char* ws; int grid; int pad; };
typedef const __attribute__((address_space(4))) Args* KArgs;
__device__ __forceinline__ KArgs kargp() { KArgs p = (KArgs)__builtin_amdgcn_kernarg_segment_ptr(); asm volatile("" : "+s"(p)); return p; }
#define PH_BEGIN KArgs ka = kargp(); unsigned char* const ws = ka->ws; float* const out = ka->out; (void)out; (void)ws; \
    const int G = ka->grid, bx = bx_fresh(), vcu = (G % 8 == 0) ? (bx % 8) * (G / 8) + bx / 8 : bx, NGW = G * NWAVES; (void)NGW; \
    const int tid = tid_fresh(), lane = tid & 63, wave = __builtin_amdgcn_readfirstlane(tid >> 6), gw = vcu * NWAVES + wave; (void)lane; (void)gw
#define IN(k) (ka->in[k])
#define XB_TMO      128
#define XB_XCNT(j)  (256  + 64 * (j))
#define XB_XSUB(j)  (1280 + 64 * (j))
#define XB_XGEN(j)  (2304 + 64 * (j))
#define XB_TOP      3328
#define XB_TOPGEN   3392
#define XCD_BAR_WORDS 3456
#define XB_SPIN_CAP (1u << 18)
__device__ __forceinline__ unsigned xb_ld(unsigned* p)              { return __hip_atomic_load(p, __ATOMIC_RELAXED, __HIP_MEMORY_SCOPE_AGENT); }
__device__ __forceinline__ unsigned xb_add(unsigned* p, unsigned v) { return __hip_atomic_fetch_add(p, v, __ATOMIC_RELAXED, __HIP_MEMORY_SCOPE_AGENT); }
__device__ __forceinline__ unsigned xb_xcc_id() { return (unsigned)__builtin_amdgcn_s_getreg((3 << 11) | 20) & 0xFu; }
#define XB_SPIN(cond, bar) do { unsigned _sp = 0; while (cond) { __builtin_amdgcn_s_sleep(1); \
    if ((++_sp & 255u) == 0u) { if (xb_ld(&(bar)[XB_TMO])) break; if (_sp > XB_SPIN_CAP) { atomicAdd(&(bar)[XB_TMO], 1u); break; } } } } while (0)
struct XcdBarrier { unsigned* bar; unsigned x; volatile LAS unsigned* st; };
__device__ __forceinline__ XcdBarrier xcd_barrier_post(unsigned* bar, volatile LAS unsigned* st) {
    XcdBarrier b; b.bar = bar; b.x = xb_xcc_id(); b.st = st;
    if (threadIdx.x == 0) (void)xb_add(&bar[XB_XCNT(b.x)], 1u);
    return b;
}
__device__ __forceinline__ void xcd_barrier_complete(unsigned* bar, unsigned x, unsigned& nloc, unsigned& nx) {
    const unsigned G = (unsigned)kargp()->grid;
    unsigned sum, cnt, mine, sp = 0u;
    for (;;) {
        sum = 0u; cnt = 0u; mine = 0u;
#pragma unroll
        for (unsigned j = 0; j < 16; ++j) { const unsigned c = xb_ld(&bar[XB_XCNT(j)]); sum += c; cnt += (c > 0u) ? 1u : 0u; mine = (j == x) ? c : mine; }
        if (sum == G) break;
        __builtin_amdgcn_s_sleep(1);
        if ((++sp & 255u) == 0u) { if (xb_ld(&bar[XB_TMO])) break; if (sp > XB_SPIN_CAP) { atomicAdd(&bar[XB_TMO], 1u); break; } }
    }
    nloc = mine > 0u ? mine : 1u; nx = cnt > 0u ? cnt : 1u;
}
__device__ __forceinline__ void xcd_barrier(const XcdBarrier& b) {
    asm volatile("s_waitcnt vmcnt(0)" ::: "memory");
    __syncthreads();
    if (threadIdx.x == 0) {
        unsigned* bar = b.bar;
        __builtin_amdgcn_s_waitcnt(0);
        unsigned nloc = b.st[0], nx = b.st[1];
        if (nloc == 0u) { xcd_barrier_complete(bar, b.x, nloc, nx); b.st[0] = nloc; b.st[1] = nx; }
        const unsigned old = xb_add(&bar[XB_XSUB(b.x)], 1u);
        const unsigned gen = old / nloc;
        if (old + 1u == (gen + 1u) * nloc) {
            __builtin_amdgcn_fence(__ATOMIC_RELEASE, "agent");
            asm volatile("s_waitcnt vmcnt(0)" ::: "memory");
            const unsigned og = xb_add(&bar[XB_TOP], 1u);
            const unsigned tg = og / nx;
            if (og + 1u == (tg + 1u) * nx) xb_add(&bar[XB_TOPGEN], 1u);
            else XB_SPIN(xb_ld(&bar[XB_TOPGEN]) == tg, bar);
            __builtin_amdgcn_fence(__ATOMIC_ACQUIRE, "agent");
            xb_add(&bar[XB_XGEN(b.x)], 1u);
            asm volatile("s_waitcnt vmcnt(0)" ::: "memory");
        } else {
            XB_SPIN(xb_ld(&bar[XB_XGEN(b.x)]) == gen, bar);
            __builtin_amdgcn_fence(__ATOMIC_ACQUIRE, "agent");
            asm volatile("s_waitcnt vmcnt(0)" ::: "memory");
        }
    }
    __syncthreads();
}

template <class Map> __device__ __forceinline__ void p0_transpose_item(const float* __restrict__ W, int ldw, int K, bf16_t* __restrict__ WT, int row_off, int nblk, LAS float* scr, int item, int lane, const Map map, const float* __restrict__ gk = nullptr) {
    const int kb = item / nblk, nb = item - kb * nblk, k0 = 64 * kb, n0 = 32 * nb;
    const int col = map(n0 + (lane & 31));
#pragma unroll 8
    for (int i = 0; i < 32; ++i) { const int kk = 2 * i + (lane >> 5); scr[kk * 33 + (lane & 31)] = col >= 0 ? W[(size_t)(k0 + kk) * ldw + col] * (gk ? gk[k0 + kk] : 1.f) : 0.f; }
    LDS_WAIT(); asm volatile("" ::: "memory");
    const int c = lane & 7;
#pragma unroll
    for (int j = 0; j < 4; ++j) { const int n = (lane >> 3) + 8 * j; const LAS float* s = scr + (8 * c) * 33 + n;
        u32x4 o; o.x = pk2(s[0 * 33], s[1 * 33]); o.y = pk2(s[2 * 33], s[3 * 33]); o.z = pk2(s[4 * 33], s[5 * 33]); o.w = pk2(s[6 * 33], s[7 * 33]);
        *(u32x4*)(WT + (size_t)(row_off + n0 + n) * K + k0 + 8 * c) = o; }
    LDS_WAIT(); asm volatile("" ::: "memory");
}
template <class Map> __device__ __forceinline__ void p0_transpose_item64(const float* __restrict__ W, int ldw, int K, bf16_t* __restrict__ WT, int row_off, int nblk, LAS float* scr, int item, int lane, const Map map, const float* __restrict__ gk = nullptr) {
    const int kb = item / nblk, nb = item - kb * nblk, k0 = 64 * kb, n0 = 64 * nb;
    const int colb = map(n0);
    f32x4 v[16];
#pragma unroll
    for (int i = 0; i < 16; ++i) { const int kk = 4 * i + (lane >> 4); v[i] = colb >= 0 ? *(const f32x4*)(W + (size_t)(k0 + kk) * ldw + colb + 4 * (lane & 15)) : (f32x4){0.f, 0.f, 0.f, 0.f}; }
    if (gk) {
#pragma unroll
        for (int i = 0; i < 16; ++i) v[i] = v[i] * gk[k0 + 4 * i + (lane >> 4)];
    }
#pragma unroll
    for (int i = 0; i < 16; ++i) { LAS float* d = scr + (4 * i + (lane >> 4)) * 65 + 4 * (lane & 15); d[0] = v[i][0]; d[1] = v[i][1]; d[2] = v[i][2]; d[3] = v[i][3]; }
    LDS_WAIT(); asm volatile("" ::: "memory");
    const int c = lane & 7;
#pragma unroll
    for (int j = 0; j < 8; ++j) { const int n = (lane >> 3) + 8 * j; const LAS float* sp = scr + (8 * c) * 65 + n;
        u32x4 o; o.x = pk2(sp[0 * 65], sp[1 * 65]); o.y = pk2(sp[2 * 65], sp[3 * 65]); o.z = pk2(sp[4 * 65], sp[5 * 65]); o.w = pk2(sp[6 * 65], sp[7 * 65]);
        *(u32x4*)(WT + (size_t)(row_off + n0 + n) * K + k0 + 8 * c) = o; }
    LDS_WAIT(); asm volatile("" ::: "memory");
}
struct MapId { int nvalid; __device__ __forceinline__ int operator()(int n) const { return n < nvalid ? n : -1; } };
struct MapQb { __device__ __forceinline__ int operator()(int n) const { const int hd = n / AQK, w = n - hd * AQK; if (w < ANOPE) return n; const int v = w - ANOPE; return hd * AQK + ANOPE + (v & 1) * 32 + (v >> 1); } };
struct MapQkvSwa { __device__ __forceinline__ int operator()(int n) const { if (n >= 2560) return n; const int w = n & 63; if (w >= 16) return n; return (n - w) + (w & 1) * 8 + (w >> 1); } };
struct MapFfn { __device__ __forceinline__ int operator()(int n) const { const int t = n >> 8, w = n & 255; return w < 128 ? t * 128 + w : DFF + t * 128 + (w - 128); } };


__device__ __forceinline__ void norm_phase(int gw, int NGW, int lane, const float* xp, const float* xs, bf16_t* xb, const bf16_t* mb, const float* slabs, int KS, const float* g_post, float* rs, float* y, bool first, bool last) {
    f32x4 gp[4][2];
#pragma unroll
    for (int j = 0; j < 4; ++j) { gp[j][0] = first ? (f32x4){0.f, 0.f, 0.f, 0.f} : ((const f32x4*)g_post)[2 * lane + 128 * j]; gp[j][1] = first ? (f32x4){0.f, 0.f, 0.f, 0.f} : ((const f32x4*)g_post)[2 * lane + 128 * j + 1]; }
    for (int row = gw; row < MALL; row += NGW) {
        f32x4 v[4][2];
        if (first) { const float* xsrc = row < MP ? xp + (size_t)row * DM : xs + (size_t)(row - MP) * DM;
#pragma unroll
            for (int j = 0; j < 4; ++j) { v[j][0] = ((const f32x4*)xsrc)[2 * lane + 128 * j]; v[j][1] = ((const f32x4*)xsrc)[2 * lane + 128 * j + 1]; }
        } else {
            f32x4 mv[4][2]; float ss = 0.f;
#pragma unroll
            for (int j = 0; j < 4; ++j) { const u32x4 w = ((const u32x4*)(xb + (size_t)row * DM))[lane + 64 * j];
                v[j][0] = (f32x4){bf2f(w.x & 0xffffu), bf2f(w.x >> 16), bf2f(w.y & 0xffffu), bf2f(w.y >> 16)}; v[j][1] = (f32x4){bf2f(w.z & 0xffffu), bf2f(w.z >> 16), bf2f(w.w & 0xffffu), bf2f(w.w >> 16)}; }
            if (row < MP) {
#pragma unroll
                for (int j = 0; j < 4; ++j) { const u32x4 w = ((const u32x4*)(mb + (size_t)row * DM))[lane + 64 * j];
                    mv[j][0] = (f32x4){bf2f(w.x & 0xffffu), bf2f(w.x >> 16), bf2f(w.y & 0xffffu), bf2f(w.y >> 16)}; mv[j][1] = (f32x4){bf2f(w.z & 0xffffu), bf2f(w.z >> 16), bf2f(w.w & 0xffffu), bf2f(w.w >> 16)}; }
            } else {
#pragma unroll
                for (int j = 0; j < 4; ++j) { mv[j][0] = (f32x4){0.f, 0.f, 0.f, 0.f}; mv[j][1] = (f32x4){0.f, 0.f, 0.f, 0.f}; }
                for (int sI = 0; sI < KS; ++sI) { const float* sp = slabs + ((size_t)sI * MS + (row - MP)) * DM;
#pragma unroll
                    for (int j = 0; j < 4; ++j) { mv[j][0] += ((const f32x4*)sp)[2 * lane + 128 * j]; mv[j][1] += ((const f32x4*)sp)[2 * lane + 128 * j + 1]; } }
            }
#pragma unroll
            for (int j = 0; j < 4; ++j)
#pragma unroll
                for (int q = 0; q < 2; ++q) ss += (mv[j][q][0] * mv[j][q][0] + mv[j][q][1] * mv[j][q][1]) + (mv[j][q][2] * mv[j][q][2] + mv[j][q][3] * mv[j][q][3]);
            const float rsm = 1.0f / sqrtf(wave_sum(ss, lane) * (1.f / DM) + EPS);
#pragma unroll
            for (int j = 0; j < 4; ++j)
#pragma unroll
                for (int q = 0; q < 2; ++q) v[j][q] = v[j][q] + mv[j][q] * rsm * gp[j][q];
        }
        if (last) {
#pragma unroll
            for (int j = 0; j < 4; ++j) { ((f32x4*)(y + (size_t)row * DM))[2 * lane + 128 * j] = v[j][0]; ((f32x4*)(y + (size_t)row * DM))[2 * lane + 128 * j + 1] = v[j][1]; }
        } else {
            float ss = 0.f;
#pragma unroll
            for (int j = 0; j < 4; ++j) { u32x4 w; w.x = pk2(v[j][0][0], v[j][0][1]); w.y = pk2(v[j][0][2], v[j][0][3]); w.z = pk2(v[j][1][0], v[j][1][1]); w.w = pk2(v[j][1][2], v[j][1][3]);
                ((u32x4*)(xb + (size_t)row * DM))[lane + 64 * j] = w;
                const float r0 = bf2f(w.x & 0xffffu), r1 = bf2f(w.x >> 16), r2 = bf2f(w.y & 0xffffu), r3 = bf2f(w.y >> 16), r4 = bf2f(w.z & 0xffffu), r5 = bf2f(w.z >> 16), r6 = bf2f(w.w & 0xffffu), r7 = bf2f(w.w >> 16);
                ss += ((r0 * r0 + r1 * r1) + (r2 * r2 + r3 * r3)) + ((r4 * r4 + r5 * r5) + (r6 * r6 + r7 * r7)); }
            const float r = 1.0f / sqrtf(wave_sum(ss, lane) * (1.f / DM) + EPS);
            if (lane == 0) rs[row] = r;
        }
    }
}

constexpr int NWAVES = 8;
constexpr int RING_BYTES = 131072, LDS_BYTES = 147456, MISC_OFF = LDS_BYTES - 256;
constexpr int STOP_AFTER = 100000;

__global__ void __launch_bounds__(NWAVES * 64, 2) mega_fwd(Args args) {
    extern __shared__ __attribute__((aligned(16))) unsigned char lds_raw[];
    LAS unsigned char* lds = (LAS unsigned char*)lds_raw;
    volatile LAS unsigned* MISC = (volatile LAS unsigned*)(lds + MISC_OFF);
    for (int u = threadIdx.x; u < (LDS_BYTES - MISC_OFF) / 4; u += NWAVES * 64) ((LAS unsigned*)(lds + MISC_OFF))[u] = 0u;
    __syncthreads();
    { KArgs ka0 = kargp(); (void)xcd_barrier_post((unsigned*)(ka0->ws + WS_CTL) + CW_BAR, MISC + 8); }
    int phase_ctr = 0;
#define GRID_BAR() do { XcdBarrier b_; b_.bar = (unsigned*)(kargp()->ws + WS_CTL) + CW_BAR; b_.x = xb_xcc_id(); b_.st = (volatile LAS unsigned*)(lds + MISC_OFF) + 8; xcd_barrier(b_); \
    if (++phase_ctr >= STOP_AFTER) return; } while (0)
#define ROPEA ((const float*)(ws + WS_ROPEA))
#define ROPEB ((const float*)(ws + WS_ROPEB))
#define XB ((bf16_t*)(ws + WS_R2))
#define MB ((bf16_t*)(ws + WS_R3))
#define SLABS ((float*)(ws + WS_R3 + 132 * MiB))
#define OB ((bf16_t*)(out + O_YP))
#define RSV ((float*)(ws + WS_RS))
#define A_QBUF ((bf16_t*)(ws + WS_R4))
#define A_ABUF ((float*)(ws + WS_R4 + 195 * MiB))
#define A_KN ((bf16_t*)(ws + WS_R4 + 195 * MiB))
#define A_VV ((bf16_t*)(ws + WS_R3))
#define A_CQ ((bf16_t*)(ws + WS_R3 + 128 * MiB))
#define A_CKVB ((bf16_t*)(ws + WS_R3 + 161 * MiB))
#define A_KPEB ((bf16_t*)(ws + WS_R3 + 194 * MiB))
#define A_OLATS ((float*)(ws + WS_R3 + 210 * MiB))
#define A_QA ((bf16_t*)(ws + WS_R3 + 210 * MiB))
#define A_CACHEK ((bf16_t*)(out + O_YP) + (size_t)MALL * DM)
#define A_CACHEVT ((bf16_t*)(ws + WS_R5))
#define A_S ((float*)(ws + WS_R5 + 66 * MiB))
#define A_WB (ws + W_MLA + (size_t)a2 * W_MLA_STRIDE)
#define B_QBUF ((bf16_t*)(ws + WS_R4))
#define B_KBUF ((bf16_t*)(ws + WS_R4 + 130 * MiB))
#define B_VBUF ((bf16_t*)(ws + WS_R4 + 163 * MiB))
#define B_KSAMP ((bf16_t*)(ws + WS_R5))
#define B_VSAMP ((bf16_t*)(ws + WS_R5 + 3 * MiB))
#define B_WB (ws + W_SWA + (size_t)a2 * W_SWA_STRIDE)
#define F_ACT ((bf16_t*)(ws + WS_R4))
#define F_GH ((float*)(ws + WS_R5))
#define F_UH ((float*)(ws + WS_R5 + 45 * MiB))
#define F_GS ((float*)(ws + WS_R5 + 68 * MiB))
#define F_US ((float*)(ws + WS_R5 + 90 * MiB))
#define F_WB (ws + W_FFN + (size_t)L * W_FFN_STRIDE)

    {
        PH_BEGIN;
        LAS float* scr = (LAS float*)(lds + wave * 16896);
        static_assert(8 * 16896 <= MISC_OFF, "P0 scratch");
        constexpr int C_FIN = 32 * (DFF2 / 64), C_FDN = (DFF / 64) * (DM / 64), C_F = C_FIN + C_FDN;
        constexpr int C_AIN = 32 * (AINP / 64), C_AQB = (QL / 64) * (AQB / 32), C_AKV = (KVL / 64) * (2048 / 64), C_AO = 32 * 32, C_UKN = 512, C_A = C_AIN + C_AQB + 2 * C_AKV + C_AO + C_UKN;
        constexpr int C_BQKV = 32 * (BQKV / 32), C_BO = 32 * 32, C_B = C_BQKV + C_BO;
        constexpr int C_RA = 4096, C_RB = 1024;
        constexpr int NITEMS = 4 * C_F + 2 * C_A + 2 * C_B + C_RA + C_RB;
        for (int it = gw; it < NITEMS; it += NGW) {
            int r = it;
            if (r < 4 * C_F) { const int L = r / C_F; r -= L * C_F; unsigned char* wb = ws + W_FFN + (size_t)L * W_FFN_STRIDE;
                if (r < C_FIN) p0_transpose_item64(IN(18) + (size_t)L * DM * DFF2, DFF2, DM, (bf16_t*)wb, 0, DFF2 / 64, scr, r, lane, MapFfn{}, IN(7) + ((size_t)L * 4 + 2) * DM);
                else p0_transpose_item64(IN(21) + (size_t)L * DFF * DM, DM, DFF, (bf16_t*)(wb + 44 * MiB), 0, DM / 64, scr, r - C_FIN, lane, MapId{DM});
                continue; }
            r -= 4 * C_F;
            if (r < 2 * C_A) { const int a = r / C_A; r -= a * C_A; unsigned char* wb = ws + W_MLA + (size_t)a * W_MLA_STRIDE;
                if (r < C_AIN) { p0_transpose_item64(IN(8) + (size_t)a * DM * AIN, AIN, DM, (bf16_t*)wb, 0, AINP / 64, scr, r, lane, MapId{AIN}, IN(7) + ((size_t)(2 * a) * 4) * DM); continue; } r -= C_AIN;
                if (r < C_AQB) { p0_transpose_item(IN(10) + (size_t)a * QL * AQB, AQB, QL, (bf16_t*)(wb + 5 * MiB), 0, AQB / 32, scr, r, lane, MapQb{}); continue; } r -= C_AQB;
                if (r < C_AKV) { p0_transpose_item64(IN(12) + (size_t)a * KVL * 2048, 2048, KVL, (bf16_t*)(wb + 8 * MiB), 0, 32, scr, r, lane, MapId{2048}); continue; } r -= C_AKV;
                if (r < C_AKV) { p0_transpose_item64(IN(13) + (size_t)a * KVL * 2048, 2048, KVL, (bf16_t*)(wb + 8 * MiB), 2048, 32, scr, r, lane, MapId{2048}); continue; } r -= C_AKV;
                if (r < C_AO) { p0_transpose_item64(IN(14) + (size_t)a * DM * DM, DM, DM, (bf16_t*)(wb + 14 * MiB), 0, 32, scr, r, lane, MapId{DM}); continue; } r -= C_AO;
                { const float* src = IN(12) + (size_t)a * KVL * 2048 + (size_t)r * 2048; bf16_t* dst = (bf16_t*)(wb + 12 * MiB) + (size_t)r * 2048;
#pragma unroll
                  for (int j = 0; j < 8; ++j) { const f32x4 t = ((const f32x4*)src)[lane + 64 * j]; u32x2 w; w.x = pk2(t[0], t[1]); w.y = pk2(t[2], t[3]); ((u32x2*)dst)[lane + 64 * j] = w; } }
                continue; }
            r -= 2 * C_A;
            if (r < 2 * C_B) { const int j = r / C_B; r -= j * C_B; unsigned char* wb = ws + W_SWA + (size_t)j * W_SWA_STRIDE;
                if (r < C_BQKV) p0_transpose_item(IN(15) + (size_t)j * DM * BQKV, BQKV, DM, (bf16_t*)wb, 0, BQKV / 32, scr, r, lane, MapQkvSwa{}, IN(7) + ((size_t)(2 * j + 1) * 4) * DM);
                else p0_transpose_item64(IN(17) + (size_t)j * DM * DM, DM, DM, (bf16_t*)(wb + 12 * MiB), 0, 32, scr, r - C_BQKV, lane, MapId{DM});
                continue; }
            r -= 2 * C_B;
            if (r < C_RA) { const int pos = 2 * r + (lane >> 5), i = lane & 31; const double inv = exp2(-(double)i * (1.0 / 32.0) * 18.931568569324174); const double ang = (double)pos * inv;
                float* d = (float*)(ws + WS_ROPEA) + ((size_t)pos * 32 + i) * 2; d[0] = (float)cos(ang); d[1] = (float)sin(ang); continue; }
            r -= C_RA;
            { const int pos = 8 * r + (lane >> 3), i = lane & 7; const double inv = exp2(-(double)i * (1.0 / 8.0) * 18.931568569324174); const double ang = (double)pos * inv;
              float* d = (float*)(ws + WS_ROPEB) + ((size_t)pos * 8 + i) * 2; d[0] = (float)cos(ang); d[1] = (float)sin(ang); }
        }
        norm_phase(gw, NGW, lane, IN(0), IN(1), XB, nullptr, nullptr, 0, nullptr, RSV, nullptr, true, false);
    }
    GRID_BAR();

    for (int L = 0; L < DEPTH; ++L) {
        const int a2 = L >> 1;
        if ((L & 1) == 0) {
            { PH_BEGIN; pg8::Gemm g{XB, (const bf16_t*)A_WB, DM, DM, DM, 0, 0}; pg8::StaticOrder S; S.init(MALL, AINP, G, bx); pg8::EpiF32<true> E{A_ABUF, AINP, 0, RSV};
              pg8::gemm_phase<pg8::EpiF32<true>, pg8::StaticOrder, true>(lds, g, S, E); }
            GRID_BAR();
            {
                PH_BEGIN;
                const float* gq = IN(9) + (size_t)a2 * QL; const float* gkv = IN(11) + (size_t)a2 * KVL;
                const float* abuf = A_ABUF; bf16_t* cqb = A_CQ; bf16_t* ckvb = A_CKVB; bf16_t* kpeb = A_KPEB; const float* ropeA = ROPEA;
                f32x4 gqv[2], gkvv[2];
#pragma unroll
                for (int j = 0; j < 2; ++j) { gqv[j] = ((const f32x4*)gq)[lane + 64 * j]; gkvv[j] = ((const f32x4*)gkv)[lane + 64 * j]; }
                for (int row = gw; row < MALL; row += NGW) {
                    const float* ar = abuf + (size_t)row * AINP;
                    f32x4 c[2], k[2]; float ssq = 0.f, ssk = 0.f;
#pragma unroll
                    for (int j = 0; j < 2; ++j) { c[j] = ((const f32x4*)ar)[lane + 64 * j]; k[j] = ((const f32x4*)(ar + 512))[lane + 64 * j];
                        ssq += (c[j][0] * c[j][0] + c[j][1] * c[j][1]) + (c[j][2] * c[j][2] + c[j][3] * c[j][3]); ssk += (k[j][0] * k[j][0] + k[j][1] * k[j][1]) + (k[j][2] * k[j][2] + k[j][3] * k[j][3]); }
                    const float pe = ar[1024 + lane];
                    const float rq = 1.0f / sqrtf(wave_sum(ssq, lane) * (1.f / QL) + EPS), rk = 1.0f / sqrtf(wave_sum(ssk, lane) * (1.f / KVL) + EPS);
                    float* ckv_out = row < MP ? out + O_CKVP + ((size_t)a2 * MP + row) * KVL : out + O_CKVS + ((size_t)a2 * MS + (row - MP)) * KVL;
                    float* kpe_out = row < MP ? out + O_KPEP + ((size_t)a2 * MP + row) * AROPE : out + O_KPES + ((size_t)a2 * MS + (row - MP)) * AROPE;
#pragma unroll
                    for (int j = 0; j < 2; ++j) { const f32x4 tq = c[j] * rq * gqv[j], tk = k[j] * rk * gkvv[j];
                        u32x2 w; w.x = pk2(tq[0], tq[1]); w.y = pk2(tq[2], tq[3]); ((u32x2*)(cqb + (size_t)row * QL))[lane + 64 * j] = w;
                        ((f32x4*)ckv_out)[lane + 64 * j] = tk;
                        u32x2 w2; w2.x = pk2(tk[0], tk[1]); w2.y = pk2(tk[2], tk[3]); ((u32x2*)(ckvb + (size_t)row * KVL))[lane + 64 * j] = w2; }
                    const float other = lane_xor(pe, lane, 32); const int i = lane & 31; const int pos = row_pos(row);
                    const float cs = ropeA[((size_t)pos * 32 + i) * 2], sn = ropeA[((size_t)pos * 32 + i) * 2 + 1];
                    const float rot = lane < 32 ? pe * cs - other * sn : other * sn + pe * cs;
                    kpe_out[lane] = rot;
                    kpeb[(size_t)row * 64 + 2 * i + (lane >> 5)] = (bf16_t)f2bf(rot);
                }
            }
            GRID_BAR();
            { PH_BEGIN; pg8::Gemm g{A_CQ, (const bf16_t*)(A_WB + 5 * MiB), QL, QL, QL, 0, 0}; pg8::StaticOrder S; S.init(MALL, AQB, G, bx); pg8::EpiQMla E{A_QBUF, ROPEA};
              pg8::gemm_phase<pg8::EpiQMla, pg8::StaticOrder, true>(lds, g, S, E); }
            {
                PH_BEGIN;
                LAS float* scr = (LAS float*)(lds + wave * 16384);
                const float* cckv = IN(2) + (size_t)a2 * NBS * PAST * KVL; const float* ckpe = IN(3) + (size_t)a2 * NBS * PAST * AROPE;
                bf16_t* cacheK = A_CACHEK; bf16_t* cacheVt = A_CACHEVT; const bf16_t* ckvb = A_CKVB; const bf16_t* kpeb = A_KPEB;
                for (int rr = gw; rr < NBS * SKN; rr += NGW) {
                    const int b = rr / SKN, j = rr - b * SKN; bf16_t* dst = cacheK + (size_t)rr * QAK;
                    u32x4 w = (u32x4){0u, 0u, 0u, 0u}; unsigned pe = 0u;
                    if (j < PAST) { const float* src = cckv + ((size_t)b * PAST + j) * KVL; const f32x4 t0 = ((const f32x4*)src)[2 * lane], t1 = ((const f32x4*)src)[2 * lane + 1];
                        w.x = pk2(t0[0], t0[1]); w.y = pk2(t0[2], t0[3]); w.z = pk2(t1[0], t1[1]); w.w = pk2(t1[2], t1[3]);
                        pe = f2bf(ckpe[((size_t)b * PAST + j) * AROPE + (lane & 1) * 32 + (lane >> 1)]); }
                    else if (j < SKEYS) { const size_t tok = (size_t)MP + b * SSEQ + (j - PAST); w = ((const u32x4*)(ckvb + tok * KVL))[lane]; pe = kpeb[tok * 64 + lane]; }
                    ((u32x4*)dst)[lane] = w; dst[512 + lane] = (bf16_t)pe; dst[576 + lane] = 0;
                }
                for (int it = gw; it < NBS * 66 * 16; it += NGW) {
                    const int b = it / (66 * 16), r2 = it - b * (66 * 16), kb = r2 >> 4, rb = r2 & 15;
#pragma unroll 8
                    for (int i = 0; i < 32; ++i) { const int kk = 2 * i + (lane >> 5), j = 64 * kb + kk, rr = 32 * rb + (lane & 31); float v = 0.f;
                        if (j < PAST) v = cckv[((size_t)b * PAST + j) * KVL + rr]; else if (j < SKEYS) v = bf2f(ckvb[((size_t)MP + b * SSEQ + (j - PAST)) * KVL + rr]);
                        scr[kk * 33 + (lane & 31)] = v; }
                    LDS_WAIT(); asm volatile("" ::: "memory");
                    const int c = lane & 7;
#pragma unroll
                    for (int jj = 0; jj < 4; ++jj) { const int n = (lane >> 3) + 8 * jj; const LAS float* s = scr + (8 * c) * 33 + n;
                        u32x4 o; o.x = pk2(s[0 * 33], s[1 * 33]); o.y = pk2(s[2 * 33], s[3 * 33]); o.z = pk2(s[4 * 33], s[5 * 33]); o.w = pk2(s[6 * 33], s[7 * 33]);
                        *(u32x4*)(cacheVt + ((size_t)b * KVL + 32 * rb + n) * SKK + 64 * kb + 8 * c) = o; }
                    LDS_WAIT(); asm volatile("" ::: "memory");
                }
            }
            GRID_BAR();
            { PH_BEGIN; bf16_t* knbuf = A_KN; bf16_t* vvbuf = A_VV;
              pg8::Gemm g{A_CKVB, (const bf16_t*)(A_WB + 8 * MiB), KVL, KVL, KVL, 0, 0}; pg8::StaticOrder S; S.init(MP, 4096, G, bx); pg8::EpiBf16 E{knbuf, 2048, 2048, (ptrdiff_t)(vvbuf - knbuf), 0};
              pg8::gemm_phase<pg8::EpiBf16, pg8::StaticOrder, true>(lds, g, S, E); }
            {
                PH_BEGIN;
                const bf16_t* qbuf = A_QBUF; const bf16_t* w_uk_nat = (const bf16_t*)(A_WB + 12 * MiB); bf16_t* qA = A_QA;
                const int r32 = lane & 31, hi = lane >> 5;
                for (int it = gw; it < 16 * 16 * 16; it += NGW) { const int tt = it >> 8, h = (it >> 4) & 15, nt = it & 15;
                    const f32x16 acc = att::wave_gemm_tile(qbuf + ((size_t)MP + 32 * tt) * AQB + h * AQK, AQB, w_uk_nat + (size_t)(32 * nt) * 2048 + h * 128, 2048, ANOPE, r32, hi);
#pragma unroll
                    for (int r = 0; r < 16; ++r) { const int tok = 32 * tt + att::crow(r, hi); qA[((size_t)tok * 16 + h) * QAK + 32 * nt + r32] = (bf16_t)f2bf(acc[r]); } }
                for (int it = gw; it < MS * 16 / 4; it += NGW) { const int row = it * 4 + (lane >> 4), l16 = lane & 15, tok = row >> 4, h = row & 15;
                    u32x4 w = (u32x4){0u, 0u, 0u, 0u}; if (l16 < 8) w = *(const u32x4*)(qbuf + ((size_t)MP + tok) * AQB + h * AQK + ANOPE + l16 * 8);
                    *(u32x4*)(qA + (size_t)row * QAK + 512 + l16 * 8) = w; }
            }
            GRID_BAR();
            { PH_BEGIN; pg8::Gemm g{A_QA, A_CACHEK, QAK, QAK, QAK, (size_t)512 * QAK, (size_t)SKN * QAK}; pg8::BatchOrder S{2, SKN / 256, NBS, G, bx}; pg8::EpiF32<false> E{A_S, SKN, (size_t)512 * SKN, nullptr};
              pg8::gemm_phase<pg8::EpiF32<false>, pg8::BatchOrder, true>(lds, g, S, E); }
            GRID_BAR();
            {
                PH_BEGIN;
                float* Sbuf = A_S;
                constexpr float C = A_SCALE * LOG2E;
                for (int rr = gw; rr < NBS * 512; rr += NGW) {
                    const float* sr = Sbuf + (size_t)rr * SKN; f32x4 v[17]; float mx = -3.0e38f;
#pragma unroll
                    for (int j = 0; j < 17; ++j) { v[j] = ((const f32x4*)sr)[lane + 64 * j]; const int c0 = 4 * lane + 256 * j;
#pragma unroll
                        for (int e = 0; e < 4; ++e) { if (c0 + e >= SKEYS) v[j][e] = -3.0e38f; mx = fmaxf(mx, v[j][e]); } }
                    mx = wave_max(mx, lane); float sum = 0.f; const float mC = mx * C;
#pragma unroll
                    for (int j = 0; j < 17; ++j) {
#pragma unroll
                        for (int e = 0; e < 4; ++e) { const float p = (4 * lane + 256 * j + e < SKEYS) ? __builtin_amdgcn_exp2f(fmaf(v[j][e], C, -mC)) : 0.f; v[j][e] = p; sum += p; } }
                    const float rinv = 1.0f / wave_sum(sum, lane);
                    asm volatile("" ::: "memory");
                    bf16_t* pr = (bf16_t*)sr;
#pragma unroll
                    for (int j = 0; j < 17; ++j) { const int c0 = 4 * lane + 256 * j; if (c0 < SKK) { u32x2 w; w.x = pk2(v[j][0] * rinv, v[j][1] * rinv); w.y = pk2(v[j][2] * rinv, v[j][3] * rinv); *(u32x2*)(pr + c0) = w; } }
                }
            }
            GRID_BAR();
            { PH_BEGIN; pg8::Gemm g{(const bf16_t*)A_S, A_CACHEVT, SKK / 3, SPITCH, SKK, (size_t)512 * SPITCH, (size_t)KVL * SKK, (size_t)(SKK / 3)}; pg8::BatchSplitOrder S{2, 2, NBS, 3, G, bx};
              pg8::EpiF32<false> E{A_OLATS, KVL, (size_t)512 * KVL, nullptr, (size_t)NBS * 512 * KVL};
              pg8::gemm_phase<pg8::EpiF32<false>, pg8::BatchSplitOrder, true>(lds, g, S, E); }
            GRID_BAR();
            {
                PH_BEGIN;
                const float* olats = A_OLATS; const bf16_t* w_kv_t = (const bf16_t*)(A_WB + 8 * MiB); bf16_t* hbuf = OB;
                const int r32 = lane & 31, hi = lane >> 5; constexpr size_t SLB = (size_t)NBS * 512 * KVL;
                for (int it = gw; it < 16 * 16 * 4; it += NGW) { const int tt = it >> 6, h = (it >> 2) & 15, vt = it & 3;
                    const float* ap = olats + ((size_t)(32 * tt + r32) * 16 + h) * KVL + hi * 8; const bf16_t* bp = w_kv_t + (size_t)(2048 + h * 128 + 32 * vt + r32) * KVL + hi * 8;
                    f32x16 acc = f32x16{};
                    for (int k0 = 0; k0 < KVL; k0 += 64) {
                        f32x4 x[4][2]; bf16x8 bq[4];
#pragma unroll
                        for (int i = 0; i < 4; ++i) { x[i][0] = *(const f32x4*)(ap + k0 + 16 * i); x[i][1] = *(const f32x4*)(ap + k0 + 16 * i + 4); bq[i] = *(const bf16x8*)(bp + k0 + 16 * i); }
#pragma unroll
                        for (int sI = 1; sI < 3; ++sI)
#pragma unroll
                            for (int i = 0; i < 4; ++i) { x[i][0] += *(const f32x4*)(ap + sI * SLB + k0 + 16 * i); x[i][1] += *(const f32x4*)(ap + sI * SLB + k0 + 16 * i + 4); }
#pragma unroll
                        for (int i = 0; i < 4; ++i) { u32x4 w; w.x = cvt_pk_bf16(x[i][0][0], x[i][0][1]); w.y = cvt_pk_bf16(x[i][0][2], x[i][0][3]); w.z = cvt_pk_bf16(x[i][1][0], x[i][1][1]); w.w = cvt_pk_bf16(x[i][1][2], x[i][1][3]);
                            acc = __builtin_amdgcn_mfma_f32_32x32x16_bf16(__builtin_bit_cast(bf16x8, w), bq[i], acc, 0, 0, 0); }
                    }
#pragma unroll
                    for (int r = 0; r < 16; ++r) { const int tok = 32 * tt + att::crow(r, hi); hbuf[((size_t)MP + tok) * DM + h * 128 + 32 * vt + r32] = (bf16_t)f2bf(acc[r]); } }
            }
            {
                PH_BEGIN;
                for (int p = vcu; p < NBP * AH * 16; p += G) { const int bh = p >> 4, s = p & 15;
                    att::mla_unit(lds, bh >> 4, bh & 15, s, A_QBUF, A_KN, A_KPEB, A_VV, OB);
                    att::mla_unit(lds, bh >> 4, bh & 15, 31 - s, A_QBUF, A_KN, A_KPEB, A_VV, OB); }
            }
            GRID_BAR();
        } else {
            { PH_BEGIN;
              float* wkp = out + O_WKP + (size_t)a2 * NBP * WIN * 512; float* wvp = out + O_WVP + (size_t)a2 * NBP * WIN * 512;
              float* wks = out + O_WKS + (size_t)a2 * NBS * WIN * 512; float* wvs = out + O_WVS + (size_t)a2 * NBS * WIN * 512;
              pg8::Gemm g{XB, (const bf16_t*)B_WB, DM, DM, DM, 0, 0}; pg8::StaticOrder S; S.init(MALL, BQKV, G, bx); pg8::EpiQkvSwa E{B_QBUF, B_KBUF, B_VBUF, B_KSAMP, B_VSAMP, ROPEB, wkp, wvp, wks, wvs, RSV};
              pg8::gemm_phase<pg8::EpiQkvSwa, pg8::StaticOrder, true>(lds, g, S, E); }
            {
                PH_BEGIN;
                float* wks = out + O_WKS + (size_t)a2 * NBS * WIN * 512; float* wvs = out + O_WVS + (size_t)a2 * NBS * WIN * 512;
                bf16_t* ksamp = B_KSAMP; bf16_t* vsamp = B_VSAMP;
                const float* pk = IN(4) + (size_t)a2 * NBS * WIN * 512; const float* pv = IN(5) + (size_t)a2 * NBS * WIN * 512;
                for (int rr = gw; rr < NBS * 192; rr += NGW) { const int b = rr / 192, j = rr - b * 192;
                    if (j >= 128 && j < 160) continue;
                    bf16_t* kd = ksamp + (size_t)rr * 512; bf16_t* vd = vsamp + (size_t)rr * 512;
                    if (j < 128) { const float* ks = pk + ((size_t)b * WIN + j) * 512; const float* vs = pv + ((size_t)b * WIN + j) * 512;
                        const f32x4 k0 = ((const f32x4*)ks)[2 * lane], k1 = ((const f32x4*)ks)[2 * lane + 1], v0 = ((const f32x4*)vs)[2 * lane], v1 = ((const f32x4*)vs)[2 * lane + 1];
                        u32x4 w; w.x = pk2(v0[0], v0[1]); w.y = pk2(v0[2], v0[3]); w.z = pk2(v1[0], v1[1]); w.w = pk2(v1[2], v1[3]); ((u32x4*)vd)[lane] = w;
                        const int c0 = 8 * lane, wq = c0 & 63;
                        if (wq < 16) {
#pragma unroll
                            for (int e = 0; e < 8; ++e) { const int vv = wq + e; kd[c0 - wq + vv] = (bf16_t)f2bf(ks[c0 - wq + (vv & 1) * 8 + (vv >> 1)]); }
                        } else { u32x4 wk; wk.x = pk2(k0[0], k0[1]); wk.y = pk2(k0[2], k0[3]); wk.z = pk2(k1[0], k1[1]); wk.w = pk2(k1[2], k1[3]); ((u32x4*)kd)[lane] = wk; }
                        if (j >= 32) { float* ko = wks + ((size_t)b * WIN + (j - 32)) * 512; float* vo = wvs + ((size_t)b * WIN + (j - 32)) * 512;
                            ((f32x4*)ko)[2 * lane] = k0; ((f32x4*)ko)[2 * lane + 1] = k1; ((f32x4*)vo)[2 * lane] = v0; ((f32x4*)vo)[2 * lane + 1] = v1; }
                    } else { ((u32x4*)kd)[lane] = (u32x4){0u, 0u, 0u, 0u}; ((u32x4*)vd)[lane] = (u32x4){0u, 0u, 0u, 0u}; }
                }
            }
            GRID_BAR();
            {
                PH_BEGIN;
                const float* sinks = IN(16) + (size_t)a2 * BH;
                const bf16_t* qbuf = B_QBUF; const bf16_t* kbuf = B_KBUF; const bf16_t* vbuf = B_VBUF; const bf16_t* ksamp = B_KSAMP; const bf16_t* vsamp = B_VSAMP; bf16_t* hbuf = OB;
                for (int it = vcu; it < NBP * 128 * BKVH + NBS * BKVH; it += G) {
                    if (it < NBP * 128 * BKVH) { const int kvh = it & 7, c = (it >> 3) & 127, b = it >> 10; const int cs = c >= 2 ? c - 2 : 0;
                        att::swa_unit(lds, qbuf + ((size_t)b * SEQ + 64 * c) * 2048 + kvh * 256, kbuf + ((size_t)b * SEQ + 64 * cs) * 512 + kvh * 64, vbuf + ((size_t)b * SEQ + 64 * cs) * 512 + kvh * 64,
                                      hbuf + ((size_t)b * SEQ + 64 * c) * 2048 + kvh * 256, c - cs + 1, false, 8, 1, sinks + kvh * 4);
                    } else { const int r = it - NBP * 128 * BKVH, kvh = r & 7, b = r >> 3;
                        att::swa_unit(lds, qbuf + ((size_t)MP + b * SSEQ) * 2048 + kvh * 256, ksamp + (size_t)b * 192 * 512 + kvh * 64, vsamp + (size_t)b * 192 * 512 + kvh * 64,
                                      hbuf + ((size_t)MP + b * SSEQ) * 2048 + kvh * 256, 3, true, 4, 0, sinks + kvh * 4); }
                }
            }
            GRID_BAR();
        }
        { PH_BEGIN; const bf16_t* w_o_t = (L & 1) ? (const bf16_t*)(B_WB + 12 * MiB) : (const bf16_t*)(A_WB + 14 * MiB);
          { pg8::Gemm g{OB, w_o_t, DM, DM, DM, 0, 0}; pg8::StaticOrder S; S.init(MP, DM, G, bx); pg8::EpiBf16 E{MB, DM, 0, 0, 0};
            pg8::gemm_phase<pg8::EpiBf16, pg8::StaticOrder, true>(lds, g, S, E); }
          { pg8::Gemm g{OB + (size_t)MP * DM, w_o_t, 256, DM, DM, 256, 256}; pg8::BatchOrder S{2, 8, 8, G, bx}; pg8::EpiF32<false> E{SLABS, DM, (size_t)MS * DM, nullptr};
            pg8::gemm_phase<pg8::EpiF32<false>, pg8::BatchOrder, true>(lds, g, S, E); } }
        GRID_BAR();
        { PH_BEGIN; const float* gL = IN(7) + (size_t)L * 4 * DM; norm_phase(gw, NGW, lane, nullptr, nullptr, XB, MB, SLABS, 8, gL + DM, RSV, nullptr, false, false); }
        GRID_BAR();
        { PH_BEGIN;
          { pg8::Gemm g{XB, (const bf16_t*)F_WB, DM, DM, DM, 0, 0}; pg8::StaticOrder S; S.init(MP, DFF2, G, bx);
            pg8::EpiFfn E{F_ACT, IN(19) + (size_t)L * 3 * DFF, IN(20) + (size_t)L * DFF, F_GH, F_UH, RSV};
            pg8::gemm_phase<pg8::EpiFfn, pg8::StaticOrder, true>(lds, g, S, E); }
          { pg8::Gemm g{XB + (size_t)MP * DM, (const bf16_t*)F_WB, 1024, DM, DM, 1024, 1024}; pg8::BatchOrder S{2, DFF2 / 256, 2, G, bx}; pg8::EpiFfnS E{F_GS, F_US, RSV};
            pg8::gemm_phase<pg8::EpiFfnS, pg8::BatchOrder, true>(lds, g, S, E); } }
        GRID_BAR();
        {
            PH_BEGIN;
            const float* st = IN(6) + (size_t)L * NBS * 2 * DFF; const float* cw = IN(19) + (size_t)L * 3 * DFF; const float* cb = IN(20) + (size_t)L * DFF;
            bf16_t* act = F_ACT; const float* Gh = F_GH; const float* Uh = F_UH; const float* Gs = F_GS; const float* Us = F_US;
            constexpr size_t SL = (size_t)MS * DFF;
            for (int it = gw; it < 1024 + MS + 8 + 32; it += NGW) {
                if (it < 1024 + MS) {
                    const float *cur, *upv, *p1 = nullptr, *p2 = nullptr; bool c2 = false, p1s = false, p2s = false; size_t R;
                    if (it < 1024) { const int blk = it >> 1, j = it & 1; R = (size_t)64 * blk + j; const int t = (int)(R & (SEQ - 1));
                        cur = Gh + ((size_t)blk * 4 + 2 + j) * DFF; upv = Uh + ((size_t)blk * 2 + j) * DFF;
                        if (j == 0) { if (t > 0) { p1 = Gh + ((size_t)(blk - 1) * 4 + 1) * DFF; p2 = Gh + ((size_t)(blk - 1) * 4 + 0) * DFF; } }
                        else { p1 = Gh + ((size_t)blk * 4 + 2) * DFF; if (t > 1) p2 = Gh + ((size_t)(blk - 1) * 4 + 1) * DFF; }
                    } else { const int rs_ = it - 1024, b = rs_ >> 5, t = rs_ & 31; R = (size_t)MP + rs_; cur = Gs + (size_t)rs_ * DFF; upv = Us + (size_t)rs_ * DFF; c2 = true;
                        if (t >= 1) { p1 = Gs + (size_t)(rs_ - 1) * DFF; p1s = true; } else p1 = st + ((size_t)b * 2 + 1) * DFF;
                        if (t >= 2) { p2 = Gs + (size_t)(rs_ - 2) * DFF; p2s = true; } else p2 = st + ((size_t)b * 2 + t) * DFF; }
                    for (int c0 = 4 * lane; c0 < DFF; c0 += 256) {
                        f32x4 g0 = *(const f32x4*)(cur + c0), u0 = *(const f32x4*)(upv + c0);
                        if (c2) { g0 += *(const f32x4*)(cur + SL + c0); u0 += *(const f32x4*)(upv + SL + c0); }
                        f32x4 a1 = p1 ? *(const f32x4*)(p1 + c0) : (f32x4){0.f, 0.f, 0.f, 0.f}, a2v = p2 ? *(const f32x4*)(p2 + c0) : (f32x4){0.f, 0.f, 0.f, 0.f};
                        if (p1s) a1 += *(const f32x4*)(p1 + SL + c0);
                        if (p2s) a2v += *(const f32x4*)(p2 + SL + c0);
                        const f32x4 w0 = *(const f32x4*)(cw + c0), w1 = *(const f32x4*)(cw + DFF + c0), w2 = *(const f32x4*)(cw + 2 * DFF + c0), bb = *(const f32x4*)(cb + c0);
                        const f32x4 cv = bb + w0 * a2v + w1 * a1 + w2 * g0; f32x4 a;
#pragma unroll
                        for (int e = 0; e < 4; ++e) a[e] = cv[e] / (1.f + __expf(-cv[e])) * u0[e];
                        u32x2 w; w.x = pk2(a[0], a[1]); w.y = pk2(a[2], a[3]); *(u32x2*)(act + R * DFF + c0) = w; }
                } else if (it < 1024 + MS + 8) { const int q = it - (1024 + MS), b = q >> 1, j = q & 1;
                    const float* src = Gh + ((size_t)(b * 128 + 127) * 4 + j) * DFF; float* dst = out + O_FCP + (((size_t)L * NBP + b) * 2 + j) * DFF;
                    for (int c0 = 4 * lane; c0 < DFF; c0 += 256) *(f32x4*)(dst + c0) = *(const f32x4*)(src + c0);
                } else { const int q = it - (1024 + MS + 8), b = q >> 1, j = q & 1;
                    const float* src = Gs + (size_t)(b * SSEQ + 30 + j) * DFF; float* dst = out + O_FCS + (((size_t)L * NBS + b) * 2 + j) * DFF;
                    for (int c0 = 4 * lane; c0 < DFF; c0 += 256) *(f32x4*)(dst + c0) = *(const f32x4*)(src + c0) + *(const f32x4*)(src + SL + c0); }
            }
        }
        GRID_BAR();
        { PH_BEGIN; const bf16_t* w_dn_t = (const bf16_t*)(F_WB + 44 * MiB);
          { pg8::Gemm g{F_ACT, w_dn_t, DFF, DFF, DFF, 0, 0}; pg8::StaticOrder S; S.init(MP, DM, G, bx); pg8::EpiBf16 E{MB, DM, 0, 0, 0};
            pg8::gemm_phase<pg8::EpiBf16, pg8::StaticOrder, true>(lds, g, S, E); }
          { pg8::Gemm g{F_ACT + (size_t)MP * DFF, w_dn_t, 512, DFF, DFF, 512, 512}; pg8::BatchOrder S{2, 8, 11, G, bx}; pg8::EpiF32<false> E{SLABS, DM, (size_t)MS * DM, nullptr};
            pg8::gemm_phase<pg8::EpiF32<false>, pg8::BatchOrder, true>(lds, g, S, E); } }
        GRID_BAR();
        { PH_BEGIN; const float* gL = IN(7) + (size_t)L * 4 * DM; norm_phase(gw, NGW, lane, nullptr, nullptr, XB, MB, SLABS, 11, gL + 3 * DM, RSV, out + O_YP, false, L + 1 == DEPTH); }
        if (L + 1 < DEPTH) GRID_BAR();
    }
#undef GRID_BAR
}

extern "C" void kernel_launch(void* const* d_in, const int* in_sizes, int n_in, void* d_out, int out_size, void* d_ws, size_t ws_size, hipStream_t stream) {
    static int grid = 0;
    if (grid == 0) {
        if (n_in != 22 || (size_t)out_size != O_END || ws_size < WS_END) { fprintf(stderr, "kernel_launch: shape mismatch: n_in %d out %d (want %zu) ws %zu (need %zu); nothing launched\n", n_in, out_size, (size_t)O_END, ws_size, (size_t)WS_END); grid = -1; return; }
        int dev = 0, cus = 0;
        if (hipGetDevice(&dev) != hipSuccess || hipDeviceGetAttribute(&cus, hipDeviceAttributeMultiprocessorCount, dev) != hipSuccess) { grid = -1; return; }
        if (hipFuncSetAttribute((const void*)mega_fwd, hipFuncAttributeMaxDynamicSharedMemorySize, LDS_BYTES) != hipSuccess) { fprintf(stderr, "kernel_launch: hipFuncSetAttribute failed\n"); grid = -1; return; }
        int per_cu = 0;
        if (hipOccupancyMaxActiveBlocksPerMultiprocessor(&per_cu, (const void*)mega_fwd, NWAVES * 64, LDS_BYTES) != hipSuccess || per_cu < 1) fprintf(stderr, "kernel_launch: occupancy query reports %d blocks per CU\n", per_cu);
        (void)hipGetLastError();
        grid = cus;
    }
    if (grid < 0) return;
    if (hipMemsetAsync((char*)d_ws + WS_CTL, 0, CTL_ZERO_BYTES, stream) != hipSuccess) { fprintf(stderr, "kernel_launch: memset failed\n"); return; }
    Args a{};
    for (int i = 0; i < 22; ++i) a.in[i] = (const float*)d_in[i];
    a.out = (float*)d_out; a.ws = (unsigned char*)d_ws; a.grid = grid; a.pad = 0;
    hipLaunchKernelGGL(mega_fwd, dim3(grid), dim3(NWAVES * 64), LDS_BYTES, stream, a);
    const hipError_t le = hipPeekAtLastError();
    if (le != hipSuccess) fprintf(stderr, "kernel_launch: launch failed: %s\n", hipGetErrorName(le));
}
```
